# Optimizing an MI355X kernel written in HIP

```python
import math
import jax
import jax.numpy as jnp
from jax import lax
import numpy as np

D_MODEL = 1024
BATCH = 16
SEQ = 256
DEPTH = 2
DEC_BATCH = 4
DEC_SEQ = 1024
PAST_LEN = 256

GRID_W = 64
HEAD_DIM = 64
D_MIX = D_MODEL
GROUP_W = D_MIX // 4
H_A = GROUP_W // HEAD_DIM
H_B = GROUP_W // HEAD_DIM
KV_B = H_B // 2
H_C = GROUP_W // HEAD_DIM
KV_C = H_C // 2
D_HY = GROUP_W
HY_ORDER = 2
HY_IN = (HY_ORDER + 1) * D_HY
SHORT_CONV = 3
FILTER_EMB = 33
FILTER_FW = 64
HY_FAST_DECAY = 0.3
HY_SLOW_DECAY = 1.5
HY_TARGET = 0.01
D_FF = 256 * ((8 * D_MODEL // 3 + 255) // 256)
N_MOD = 9
MLSTM_CHUNK = 64
Q_BLOCK = 128
WINDOW = 128
ROPE_BASE = 10000.0
EPS = 1e-6
IN_SIZES = (GROUP_W, GROUP_W, GROUP_W, GROUP_W, 2 * H_A, 2 * H_A,
            GROUP_W, KV_B * HEAD_DIM, KV_B * HEAD_DIM,
            GROUP_W, KV_C * HEAD_DIM, KV_C * HEAD_DIM,
            HY_IN)
N_IN = sum(IN_SIZES)
F32 = jnp.float32

kernel_name = 'hybrid_diffusion_trunk_step'


def rmsnorm(x, g):
    xf = x.astype(F32)
    y = xf * lax.rsqrt(jnp.mean(xf * xf, -1, keepdims=True) + EPS)
    return (y * g.astype(F32)).astype(x.dtype)


def swiglu(h, wg, wu, wd):
    return (jax.nn.silu(h @ wg) * (h @ wu)) @ wd


def split_in(u):
    idx = np.cumsum(IN_SIZES)[:-1].tolist()
    return jnp.split(u, idx, axis=-1)


def _heads(a, nh):
    return a.reshape(a.shape[0], a.shape[1], nh, HEAD_DIM)


def _sink(s):
    return s.astype(F32).reshape(KV_C, H_C // KV_C, 1, 1)


def grid_positions(n):
    rows = n // GRID_W
    r, c = jnp.meshgrid(jnp.arange(rows), jnp.arange(GRID_W), indexing='ij')
    return r.reshape(-1).astype(F32), c.reshape(-1).astype(F32)


def rope_1d(x, pos):
    half = x.shape[-1] // 2
    inv = ROPE_BASE ** (-jnp.arange(half, dtype=F32) / half)
    ang = pos[:, None] * inv[None, :]
    cos = jnp.cos(ang)[None, :, None, :]
    sin = jnp.sin(ang)[None, :, None, :]
    xf = x.astype(F32)
    x1, x2 = xf[..., :half], xf[..., half:]
    return jnp.concatenate([x1 * cos - x2 * sin, x2 * cos + x1 * sin], -1).astype(x.dtype)


def rope_2d(x, row, col):
    h = x.shape[-1] // 2
    return jnp.concatenate([rope_1d(x[..., :h], row), rope_1d(x[..., h:], col)], -1)


def attn_probs(s, sink):
    if sink is None:
        return jax.nn.softmax(s, axis=-1)
    m = jnp.maximum(jnp.max(s, -1, keepdims=True), sink)
    e = jnp.exp(s - m)
    return e / (jnp.sum(e, -1, keepdims=True) + jnp.exp(sink - m))


def attend_blocks(q, k, v, sink):
    b, n, h, d = q.shape
    kv = k.shape[2]
    g = h // kv
    nb = n // Q_BLOCK
    qb = (q * d ** -0.5).reshape(b, nb, Q_BLOCK, kv, g, d).transpose(1, 0, 2, 3, 4, 5)

    def one(qblk):
        s = jnp.einsum('bqkgd,bmkd->bkgqm', qblk, k).astype(F32)
        p = attn_probs(s, sink)
        return jnp.einsum('bkgqm,bmkd->bqkgd', p.astype(v.dtype), v)

    o = lax.map(one, qb)
    return o.transpose(1, 0, 2, 3, 4, 5).reshape(b, n, h * d)


def swa_banded(q, k, v, k_ctx, v_ctx, sink):
    b, n, h, d = q.shape
    kv = k.shape[2]
    g = h // kv
    nb = n // Q_BLOCK
    side = -(-WINDOW // Q_BLOCK)
    padn = side * Q_BLOCK

    def band(a):
        ap = jnp.pad(a, ((0, 0), (padn, padn), (0, 0), (0, 0))).reshape(b, nb + 2 * side, Q_BLOCK, kv, d)
        return jnp.concatenate([ap[:, j:j + nb] for j in range(2 * side + 1)], axis=2)

    kw, vw = band(k), band(v)
    mw = (2 * side + 1) * Q_BLOCK
    qpos = jnp.arange(nb)[:, None] * Q_BLOCK + jnp.arange(Q_BLOCK)[None, :]
    kpos = jnp.arange(nb)[:, None] * Q_BLOCK - padn + jnp.arange(mw)[None, :]
    kp = kpos[:, None, :]
    valid = (jnp.abs(kp - qpos[:, :, None]) <= WINDOW) & (kp >= 0) & (kp < n)
    qb = (q * d ** -0.5).reshape(b, nb, Q_BLOCK, kv, g, d)
    s_ctx = jnp.einsum('bnqkgd,bmkd->bnkgqm', qb, k_ctx).astype(F32)
    s_win = jnp.einsum('bnqkgd,bnmkd->bnkgqm', qb, kw).astype(F32)
    s_win = jnp.where(valid[None, :, None, None], s_win, -jnp.inf)
    p = attn_probs(jnp.concatenate([s_ctx, s_win], -1), sink)
    lc = k_ctx.shape[1]
    o = (jnp.einsum('bnkgqm,bmkd->bnqkgd', p[..., :lc].astype(v.dtype), v_ctx)
         + jnp.einsum('bnkgqm,bnmkd->bnqkgd', p[..., lc:].astype(v.dtype), vw))
    return o.reshape(b, n, h * d)


def mlstm_chunked(q, k, v, ig, fg, state):
    b, h, L, dk = q.shape
    nc = L // MLSTM_CHUNK
    k = k * (dk ** -0.5)
    logf = jax.nn.log_sigmoid(fg)

    def chunks(a):
        return jnp.moveaxis(a.reshape(b, h, nc, MLSTM_CHUNK, *a.shape[3:]), 2, 0)

    tri = jnp.arange(MLSTM_CHUNK)[:, None] >= jnp.arange(MLSTM_CHUNK)[None, :]

    def step(carry, inp):
        C, n, m = carry
        qc, kc, vc, ic, lf = inp
        bcum = jnp.cumsum(lf, -1)
        dmat = jnp.where(tri, bcum[..., :, None] - bcum[..., None, :] + ic[..., None, :], -jnp.inf)
        inter = bcum + m[..., None]
        mt = jnp.maximum(jnp.max(dmat, -1), inter)
        s = jnp.einsum('bhtd,bhsd->bhts', qc, kc) * jnp.exp(dmat - mt[..., None])
        w_inter = jnp.exp(inter - mt)
        num = jnp.einsum('bhts,bhse->bhte', s, vc) + w_inter[..., None] * jnp.einsum('bhtd,bhde->bhte', qc, C)
        den = jnp.sum(s, -1) + w_inter * jnp.einsum('bhtd,bhd->bht', qc, n)
        hc = num / jnp.maximum(jnp.abs(den), jnp.exp(-mt))[..., None]
        btot = bcum[..., -1]
        wlog = btot[..., None] - bcum + ic
        m_new = jnp.maximum(btot + m, jnp.max(wlog, -1))
        wk = jnp.exp(wlog - m_new[..., None])
        decay = jnp.exp(btot + m - m_new)
        C_new = decay[..., None, None] * C + jnp.einsum('bhs,bhsd,bhse->bhde', wk, kc, vc)
        n_new = decay[..., None] * n + jnp.einsum('bhs,bhsd->bhd', wk, kc)
        return (C_new, n_new, m_new), hc

    final, hs = lax.scan(step, state, (chunks(q), chunks(k), chunks(v), chunks(ig), chunks(logf)))
    hs = jnp.moveaxis(hs, 0, 2).reshape(b, h, L, v.shape[-1])
    return hs, final


def mlstm_bidir(q, k, v, o, ig, fg, state_f, state_b, p):
    b, L, _ = q.shape

    def heads(a):
        return a.astype(F32).reshape(b, L, H_A, HEAD_DIM).transpose(0, 2, 1, 3)

    gb = p['b_gates'].astype(F32)

    def gates(a, bias):
        return (a.astype(F32) + bias).reshape(b, L, 2, H_A).transpose(2, 0, 3, 1)

    igh = gates(ig, gb[:2 * H_A])
    fgh = gates(fg, gb[2 * H_A:])
    qh, kh, vh = heads(q), heads(k), heads(v)
    h_f, st_f = mlstm_chunked(qh, kh, vh, igh[0], fgh[0], state_f)

    def rev(a):
        return jnp.flip(a, axis=2)

    h_b, st_b = mlstm_chunked(rev(qh), rev(kh), rev(vh), rev(igh[1]), rev(fgh[1]), state_b)
    hs = (h_f + rev(h_b)).transpose(0, 2, 1, 3)
    hs = hs * lax.rsqrt(jnp.mean(hs * hs, -1, keepdims=True) + EPS)
    y = hs.reshape(b, L, GROUP_W) * p['g_mlstm'].astype(F32) * jax.nn.sigmoid(o.astype(F32))
    return y.astype(q.dtype), st_f, st_b


def hyena_filter(L, p):
    pos = jnp.arange(L, dtype=F32)
    bands = (FILTER_EMB - 1) // 2
    t01 = pos / max(L - 1, 1)
    ang = (2.0 * math.pi / L) * pos[:, None] * jnp.linspace(1e-4, bands - 1, bands, dtype=F32)[None, :]
    feats = jnp.concatenate([t01[:, None], jnp.cos(ang), -jnp.sin(ang)], -1)
    fr = p['filt_freq'].astype(F32)
    z = jnp.sin(fr * (feats @ p['filt_w1'].astype(F32) + p['filt_b1'].astype(F32)))
    z = jnp.sin(fr * (z @ p['filt_w2'].astype(F32) + p['filt_b2'].astype(F32)))
    filt = z @ p['filt_w3'].astype(F32) + p['filt_b3'].astype(F32)
    centre = L // 2
    dist = jnp.abs(pos - centre) / max(centre, 1)
    deltas = jnp.abs(jnp.linspace(math.log(HY_TARGET) / HY_SLOW_DECAY, math.log(HY_TARGET) / HY_FAST_DECAY, D_HY, dtype=F32))
    return filt * jnp.exp(-dist[:, None] * deltas[None, :])


def hyena_mixer(u, p):
    b, L, _ = u.shape
    half = SHORT_CONV // 2
    up = jnp.pad(u, ((0, 0), (half, half), (0, 0)))
    cw = p['conv_w']
    uc = sum(cw[j] * up[:, j:j + L] for j in range(SHORT_CONV)) + p['conv_b']
    x0, x1, v = jnp.split(uc.astype(F32), HY_ORDER + 1, axis=-1)
    z = x1 * v
    n_fft = 2 * L
    zf = jnp.fft.rfft(z, n=n_fft, axis=1)
    hf = jnp.fft.rfft(hyena_filter(L, p), n=n_fft, axis=0)
    yf = jnp.fft.irfft(zf * hf[None], n=n_fft, axis=1)
    y = yf[:, L // 2:L // 2 + L] + z * p['hyena_bias'].astype(F32)
    return (x0 * y).astype(u.dtype)


def mix_context(h, p):
    b = h.shape[0]
    aq, ak, av, ao, ai, af, bq, bk, bv, cq, ck, cv, du = split_in(h @ p['w_in'])
    zero = (jnp.zeros((b, H_A, HEAD_DIM, HEAD_DIM), F32), jnp.zeros((b, H_A, HEAD_DIM), F32), jnp.zeros((b, H_A), F32))
    ya, st_f, st_b = mlstm_bidir(aq, ak, av, ao, ai, af, zero, zero, p)
    kB = rmsnorm(_heads(bk, KV_B), p['g_knorm'])
    vB = _heads(bv, KV_B)
    yb = attend_blocks(rmsnorm(_heads(bq, H_B), p['g_qnorm']), kB, vB, None)
    kC = _heads(ck, KV_C)
    vC = _heads(cv, KV_C)
    yc = attend_blocks(_heads(cq, H_C), kC, vC, _sink(p['sinks']))
    yd = hyena_mixer(du, p)
    y = jnp.concatenate([ya, yb, yc, yd], -1) @ p['w_out']
    sC = jnp.stack([st_f[0], st_b[0]], axis=1)
    sn = jnp.stack([st_f[1], st_b[1]], axis=1)
    sm = jnp.stack([st_f[2], st_b[2]], axis=1)
    return y, (sC, sn, sm, kB, vB, kC, vC)


def mix_latent(h, cache, p):
    b, n, _ = h.shape
    row, col = grid_positions(n)
    sC, sn, sm, gk, gv, sk, sv = cache
    aq, ak, av, ao, ai, af, bq, bk, bv, cq, ck, cv, du = split_in(h @ p['w_in'])
    st_f = (sC[:, 0].astype(F32), sn[:, 0].astype(F32), sm[:, 0].astype(F32))
    st_b = (sC[:, 1].astype(F32), sn[:, 1].astype(F32), sm[:, 1].astype(F32))
    ya, _, _ = mlstm_bidir(aq, ak, av, ao, ai, af, st_f, st_b, p)
    qB = rope_2d(rmsnorm(_heads(bq, H_B), p['g_qnorm']), row, col)
    kB = rope_2d(rmsnorm(_heads(bk, KV_B), p['g_knorm']), row, col)
    vB = _heads(bv, KV_B)
    yb = attend_blocks(qB, jnp.concatenate([gk.astype(kB.dtype), kB], 1),
                       jnp.concatenate([gv.astype(vB.dtype), vB], 1), None)
    qC = rope_2d(_heads(cq, H_C), row, col)
    kC = rope_2d(_heads(ck, KV_C), row, col)
    vC = _heads(cv, KV_C)
    yc = swa_banded(qC, kC, vC, sk.astype(kC.dtype), sv.astype(vC.dtype), _sink(p['sinks']))
    yd = hyena_mixer(du, p)
    return jnp.concatenate([ya, yb, yc, yd], -1) @ p['w_out'], None


def trunk_layer(x, mod, p, mixer):
    def part(i):
        return mod[:, i][:, None, :]

    h = rmsnorm(x, p['g_ff1']) * (1 + part(1)) + part(0)
    x = x + 0.5 * part(2) * swiglu(h, p['w1_gate'], p['w1_up'], p['w1_down'])
    h = rmsnorm(x, p['g_mix']) * (1 + part(4)) + part(3)
    y, ctx_state = mixer(h)
    x = x + part(5) * y
    h = rmsnorm(x, p['g_ff2']) * (1 + part(7)) + part(6)
    x = x + 0.5 * part(8) * swiglu(h, p['w2_gate'], p['w2_up'], p['w2_down'])
    return x, ctx_state


def setup_inputs(seed: int = 0) -> dict:
    key = jax.random.key(seed)
    keys = list(jax.random.split(key, 64))

    def nrm(shape, scale=1.0):
        return jax.random.normal(keys.pop(), shape, F32) * scale

    def gain(shape):
        return 1.0 + nrm(shape, 0.02)

    L = DEPTH
    i_bias = nrm((L, 2 * H_A), 0.1)
    f_bias = jnp.tile(jnp.linspace(3.0, 6.0, H_A), 2)[None, :] + nrm((L, 2 * H_A), 0.1)
    return {
        'x_prompt': nrm((BATCH, SEQ, D_MODEL)),
        'x_sample': nrm((DEC_BATCH, DEC_SEQ, D_MODEL)),
        'state_mlstm_C': nrm((DEC_BATCH, DEPTH, 2, H_A, HEAD_DIM, HEAD_DIM), 0.3),
        'state_mlstm_n': nrm((DEC_BATCH, DEPTH, 2, H_A, HEAD_DIM), 0.3),
        'state_mlstm_m': nrm((DEC_BATCH, DEPTH, 2, H_A)),
        'cache_gattn_k': nrm((DEC_BATCH, DEPTH, PAST_LEN, KV_B, HEAD_DIM)),
        'cache_gattn_v': nrm((DEC_BATCH, DEPTH, PAST_LEN, KV_B, HEAD_DIM)),
        'cache_swa_k': nrm((DEC_BATCH, DEPTH, PAST_LEN, KV_C, HEAD_DIM)),
        'cache_swa_v': nrm((DEC_BATCH, DEPTH, PAST_LEN, KV_C, HEAD_DIM)),
        'c': nrm((DEC_BATCH, D_MODEL)),
        'c_ctx': nrm((D_MODEL,)),
        'w_ada': nrm((L, D_MODEL, N_MOD * D_MODEL), 0.5 * D_MODEL ** -0.5),
        'b_ada': nrm((L, N_MOD * D_MODEL), 0.01),
        'g_ff1': gain((L, D_MODEL)),
        'w1_gate': nrm((L, D_MODEL, D_FF), D_MODEL ** -0.5),
        'w1_up': nrm((L, D_MODEL, D_FF), D_MODEL ** -0.5),
        'w1_down': nrm((L, D_FF, D_MODEL), D_FF ** -0.5),
        'g_mix': gain((L, D_MODEL)),
        'w_in': nrm((L, D_MODEL, N_IN), D_MODEL ** -0.5),
        'b_gates': jnp.concatenate([i_bias, f_bias], -1),
        'g_mlstm': gain((L, GROUP_W)),
        'g_qnorm': gain((L, HEAD_DIM)),
        'g_knorm': gain((L, HEAD_DIM)),
        'sinks': nrm((L, H_C), 0.5),
        'conv_w': nrm((L, SHORT_CONV, HY_IN), 0.5),
        'conv_b': nrm((L, HY_IN), 0.02),
        'filt_w1': nrm((L, FILTER_EMB, FILTER_FW), FILTER_EMB ** -0.5),
        'filt_b1': nrm((L, FILTER_FW), 0.1),
        'filt_w2': nrm((L, FILTER_FW, FILTER_FW), FILTER_FW ** -0.5),
        'filt_b2': nrm((L, FILTER_FW), 0.1),
        'filt_w3': nrm((L, FILTER_FW, D_HY), 0.05 * FILTER_FW ** -0.5),
        'filt_b3': nrm((L, D_HY), 0.01),
        'filt_freq': 1.0 + nrm((L, FILTER_FW), 0.1),
        'hyena_bias': nrm((L, D_HY), 0.1),
        'w_out': nrm((L, D_MIX, D_MODEL), D_MIX ** -0.5),
        'g_ff2': gain((L, D_MODEL)),
        'w2_gate': nrm((L, D_MODEL, D_FF), D_MODEL ** -0.5),
        'w2_up': nrm((L, D_MODEL, D_FF), D_MODEL ** -0.5),
        'w2_down': nrm((L, D_FF, D_MODEL), D_FF ** -0.5),
        'g_final': gain((D_MODEL,)),
    }


def reference(x_prompt, x_sample, state_mlstm_C, state_mlstm_n, state_mlstm_m,
              cache_gattn_k, cache_gattn_v, cache_swa_k, cache_swa_v, c, c_ctx,
              w_ada, b_ada, g_ff1, w1_gate, w1_up, w1_down, g_mix, w_in, b_gates,
              g_mlstm, g_qnorm, g_knorm, sinks, conv_w, conv_b, filt_w1, filt_b1,
              filt_w2, filt_b2, filt_w3, filt_b3, filt_freq, hyena_bias, w_out,
              g_ff2, w2_gate, w2_up, w2_down, g_final):
    new_C, new_n, new_m, new_gk, new_gv, new_sk, new_sv = [], [], [], [], [], [], []
    xp, xs = x_prompt, x_sample
    for l in range(DEPTH):
        p = {
            'g_ff1': g_ff1[l], 'w1_gate': w1_gate[l], 'w1_up': w1_up[l], 'w1_down': w1_down[l],
            'g_mix': g_mix[l], 'w_in': w_in[l], 'b_gates': b_gates[l], 'g_mlstm': g_mlstm[l],
            'g_qnorm': g_qnorm[l], 'g_knorm': g_knorm[l], 'sinks': sinks[l],
            'conv_w': conv_w[l], 'conv_b': conv_b[l],
            'filt_w1': filt_w1[l], 'filt_b1': filt_b1[l], 'filt_w2': filt_w2[l], 'filt_b2': filt_b2[l],
            'filt_w3': filt_w3[l], 'filt_b3': filt_b3[l], 'filt_freq': filt_freq[l],
            'hyena_bias': hyena_bias[l], 'w_out': w_out[l],
            'g_ff2': g_ff2[l], 'w2_gate': w2_gate[l], 'w2_up': w2_up[l], 'w2_down': w2_down[l],
        }
        mod_ctx = (jax.nn.silu(c_ctx) @ w_ada[l] + b_ada[l]).reshape(1, N_MOD, -1)
        mod_lat = (jax.nn.silu(c) @ w_ada[l] + b_ada[l]).reshape(c.shape[0], N_MOD, -1)
        xp, st = trunk_layer(xp, mod_ctx, p, lambda h: mix_context(h, p))
        new_C.append(st[0]); new_n.append(st[1]); new_m.append(st[2])
        new_gk.append(st[3]); new_gv.append(st[4]); new_sk.append(st[5]); new_sv.append(st[6])
        cache_l = (state_mlstm_C[:, l], state_mlstm_n[:, l], state_mlstm_m[:, l],
                   cache_gattn_k[:, l], cache_gattn_v[:, l], cache_swa_k[:, l], cache_swa_v[:, l])
        xs, _ = trunk_layer(xs, mod_lat, p, lambda h: mix_latent(h, cache_l, p))
    y_prompt = rmsnorm(xp, g_final)
    y_sample = rmsnorm(xs, g_final)
    return (y_prompt, y_sample,
            jnp.stack(new_C, axis=1), jnp.stack(new_n, axis=1), jnp.stack(new_m, axis=1),
            jnp.stack(new_gk, axis=1), jnp.stack(new_gv, axis=1),
            jnp.stack(new_sk, axis=1), jnp.stack(new_sv, axis=1))
```

```cpp
#include <hip/hip_runtime.h>
#include <hip/hip_cooperative_groups.h>
#include <cstdio>
namespace cg = cooperative_groups;

#define DI __device__ __forceinline__
typedef unsigned short bf16_t;
using bf16x8 = __attribute__((ext_vector_type(8))) short;
using bf16x4 = __attribute__((ext_vector_type(4))) short;
using f32x4 = __attribute__((ext_vector_type(4))) float;

constexpr int NTOK = 8192, NCTX = 4096, DM = 1024, DFF = 2816, NIN = 2832, NGU = 5632;
constexpr int NMOD = 9216;
constexpr float EPS = 1e-6f;

enum { I_XP = 0, I_XS, I_SC, I_SN, I_SM, I_CGK, I_CGV, I_CSK, I_CSV, I_C, I_CCTX, I_WADA, I_BADA, I_GFF1,
       I_W1G, I_W1U, I_W1D, I_GMIX, I_WIN, I_BG, I_GML, I_GQN, I_GKN, I_SINK, I_CW, I_CB, I_FW1, I_FB1,
       I_FW2, I_FB2, I_FW3, I_FB3, I_FFR, I_HBIAS, I_WOUT, I_GFF2, I_W2G, I_W2U, I_W2D, I_GFIN };

constexpr size_t O_Y = 0, O_NC = 8388608, O_NN = 9437184, O_NM = 9453568, O_GK = 9453824, O_GV = 10502400,
                 O_SK = 11550976, O_SV = 12599552;

constexpr size_t MiB = 1u << 20;
constexpr size_t OFF_WT = 0, OFF_X = 44 * MiB, OFF_H = 76 * MiB, OFF_U = 92 * MiB, OFF_QB = 181 * MiB,
                 OFF_QC = 185 * MiB, OFF_KB = 189 * MiB, OFF_VB = 192 * MiB, OFF_KC = 195 * MiB, OFF_VC = 198 * MiB,
                 OFF_HF = 201 * MiB, OFF_HB = 209 * MiB, OFF_MOD = 217 * MiB, OFF_FILT = 218 * MiB,
                 OFF_ROPE = 221 * MiB, OFF_CTR = 222 * MiB, OFF_BAR = 223 * MiB;
constexpr size_t WT_GU1 = 0, WT_D1 = 5767168, WT_IN = 8650752, WT_OUT = 11550720, WT_GU2 = 12599296, WT_D2 = 18366464;

#ifndef REP_GEMM
#define REP_GEMM 1
#endif
#ifndef REP_MIXER
#define REP_MIXER 1
#endif
#ifndef REP_SMALL
#define REP_SMALL 1
#endif
#ifndef REP_PRO
#define REP_PRO 1
#endif
#define REP_RES 1
#define REP_MASK 15
#define REP_BAR 1
constexpr int LDS_BYTES = 79 * 1024;

struct Params {
  const float* in[40];
  float* out;
  char* ws;
};

DI const float* pin(const Params& p, int i) {
  asm volatile("" : "+s"(i));
  return p.in[i];
}
DI char* pws(const Params& p, size_t off) {
  asm volatile("" : "+s"(off));
  return p.ws + off;
}
DI float* pout(const Params& p) {
  int z = 0;
  asm volatile("" : "+s"(z));
  return p.out + z;
}
DI int otid() {
  int t = threadIdx.x;
  asm volatile("" : "+v"(t));
  return t;
}
DI int obid() {
  int b = blockIdx.x;
  asm volatile("" : "+s"(b));
  return b;
}
DI bf16_t f2bf(float x) {
  unsigned u = __float_as_uint(x);
  u += 0x7fffu + ((u >> 16) & 1u);
  return (bf16_t)(u >> 16);
}
DI float bf2f(bf16_t h) { return __uint_as_float(((unsigned)h) << 16); }
DI unsigned pack2(float a, float b) { return (unsigned)f2bf(a) | ((unsigned)f2bf(b) << 16); }
template <int K>
DI float shx(float v) {
  if constexpr (K < 32) return __int_as_float(__builtin_amdgcn_ds_swizzle(__float_as_int(v), (K << 10) | 0x1f));
  else return __shfl_xor(v, K);
}
DI float wave_sum(float v) {
  v += shx<32>(v); v += shx<16>(v); v += shx<8>(v); v += shx<4>(v); v += shx<2>(v); v += shx<1>(v);
  return v;
}
DI float sigmoidf_(float x) { return 1.f / (1.f + __expf(-x)); }
DI int mod_index(int row) { return row < NCTX ? 0 : 1 + ((row - NCTX) >> 10); }
#define MFMA16(a, b, c) __builtin_amdgcn_mfma_f32_16x16x32_bf16((a), (b), (c), 0, 0, 0)


#define XB_TMO      128
#define XB_XCNT(j)  (256  + 64 * (j))
#define XB_XSUB(j)  (1280 + 64 * (j))
#define XB_XGEN(j)  (2304 + 64 * (j))
#define XB_TOP      3328
#define XB_TOPGEN   3392
#define XCD_BAR_WORDS 3456
#define XB_SPIN_CAP (1u << 20)
#define LAS __attribute__((address_space(3)))
DI unsigned xb_ld(unsigned* p) { return __hip_atomic_load(p, __ATOMIC_RELAXED, __HIP_MEMORY_SCOPE_AGENT); }
DI unsigned xb_add(unsigned* p, unsigned v) { return __hip_atomic_fetch_add(p, v, __ATOMIC_RELAXED, __HIP_MEMORY_SCOPE_AGENT); }
DI unsigned xb_xcc_id() { return (unsigned)__builtin_amdgcn_s_getreg((3 << 11) | 20) & 0xFu; }
#define XB_SPIN(cond, bar) do { unsigned _sp = 0; while (cond) { __builtin_amdgcn_s_sleep(1); \
    if ((++_sp & 255u) == 0u) { if (xb_ld(&(bar)[XB_TMO])) break; if (_sp > XB_SPIN_CAP) { atomicAdd(&(bar)[XB_TMO], 1u); break; } } } } while (0)
struct XcdBarrier {
  unsigned* bar; unsigned x;
  volatile LAS unsigned* st;
};
DI XcdBarrier xcd_barrier_post(unsigned* bar, volatile LAS unsigned* st) {
  XcdBarrier b; b.bar = bar; b.x = xb_xcc_id(); b.st = st;
  if (threadIdx.x == 0) (void)xb_add(&bar[XB_XCNT(b.x)], 1u);
  return b;
}
DI void xcd_barrier_complete(unsigned* bar, unsigned x, unsigned& nloc, unsigned& nx) {
  const unsigned G = gridDim.x * gridDim.y * gridDim.z;
  unsigned sum, cnt, mine, sp = 0u;
  for (;;) {
    sum = 0u; cnt = 0u; mine = 0u;
#pragma unroll 1
    for (unsigned j = 0; j < 16; ++j) { const unsigned c = xb_ld(&bar[XB_XCNT(j)]); sum += c; cnt += (c > 0u) ? 1u : 0u; mine = (j == x) ? c : mine; }
    if (sum == G) break;
    __builtin_amdgcn_s_sleep(1);
    if ((++sp & 255u) == 0u) { if (xb_ld(&bar[XB_TMO])) break; if (sp > XB_SPIN_CAP) { atomicAdd(&bar[XB_TMO], 1u); break; } }
  }
  nloc = mine > 0u ? mine : 1u; nx = cnt > 0u ? cnt : 1u;
}
DI void xcd_barrier(const XcdBarrier& b) {
  asm volatile("s_waitcnt vmcnt(0)" ::: "memory");
  __syncthreads();
  if (threadIdx.x == 0) {
    unsigned* bar = b.bar;
    __builtin_amdgcn_s_waitcnt(0);
    unsigned nloc = b.st[0], nx = b.st[1];
    if (nloc == 0u) { xcd_barrier_complete(bar, b.x, nloc, nx); b.st[0] = nloc; b.st[1] = nx; }
    const unsigned old = xb_add(&bar[XB_XSUB(b.x)], 1u);
    const unsigned gen = old / nloc;
    if (old + 1u == (gen + 1u) * nloc) {
      __builtin_amdgcn_fence(__ATOMIC_RELEASE, "agent");
      asm volatile("s_waitcnt vmcnt(0)" ::: "memory");
      const unsigned og = xb_add(&bar[XB_TOP], 1u);
      const unsigned tg = og / nx;
      if (og + 1u == (tg + 1u) * nx) xb_add(&bar[XB_TOPGEN], 1u);
      else XB_SPIN(xb_ld(&bar[XB_TOPGEN]) == tg, bar);
      __builtin_amdgcn_fence(__ATOMIC_ACQUIRE, "agent");
      xb_add(&bar[XB_XGEN(b.x)], 1u);
      asm volatile("s_waitcnt vmcnt(0)" ::: "memory");
    } else {
      XB_SPIN(xb_ld(&bar[XB_XGEN(b.x)]) == gen, bar);
      __builtin_amdgcn_fence(__ATOMIC_ACQUIRE, "agent");
      asm volatile("s_waitcnt vmcnt(0)" ::: "memory");
    }
  }
  __syncthreads();
}

DI void mod_item(const Params& p, int it, char* smem) {
  const int tid = otid();
  float* sv = (float*)smem;
  float* red = sv + 5 * 1024;
  const int l = it / 144, j0 = (it % 144) * 64;
  __syncthreads();
  for (int i = tid; i < 5120; i += 256) {
    int v = i >> 10, k = i & 1023;
    float c = (v == 0) ? pin(p, I_CCTX)[k] : pin(p, I_C)[(v - 1) * 1024 + k];
    sv[i] = c / (1.f + expf(-c));
  }
  __syncthreads();
  const int c4 = tid & 15, kg = tid >> 4;
  float acc[5][4];
#pragma unroll
  for (int v = 0; v < 5; ++v)
#pragma unroll
    for (int i = 0; i < 4; ++i) acc[v][i] = 0.f;
  const float* w = pin(p, I_WADA) + (size_t)l * 1024 * NMOD + j0 + c4 * 4;
#pragma unroll 1
  for (int k0 = kg; k0 < 1024; k0 += 128) {
    float4 wv[8];
#pragma unroll
    for (int u = 0; u < 8; ++u) wv[u] = *(const float4*)(w + (size_t)(k0 + 16 * u) * NMOD);
#pragma unroll
    for (int u = 0; u < 8; ++u)
#pragma unroll
      for (int v = 0; v < 5; ++v) {
        float s = sv[v * 1024 + k0 + 16 * u];
        acc[v][0] += s * wv[u].x; acc[v][1] += s * wv[u].y; acc[v][2] += s * wv[u].z; acc[v][3] += s * wv[u].w;
      }
  }
#pragma unroll
  for (int v = 0; v < 5; ++v)
#pragma unroll
    for (int i = 0; i < 4; ++i) red[(kg * 5 + v) * 64 + c4 * 4 + i] = acc[v][i];
  __syncthreads();
  for (int o = tid; o < 320; o += 256) {
    int v = o >> 6, c = o & 63;
    float s = 0.f;
    for (int k = 0; k < 16; ++k) s += red[(k * 5 + v) * 64 + c];
    s += pin(p, I_BADA)[l * NMOD + j0 + c];
    ((float*)(pws(p, OFF_MOD)))[(size_t)(l * 5 + v) * NMOD + j0 + c] = s;
  }
}

DI void filt_item(const Params& p, int it, char* smem) {
  const int tid = otid(), q = tid >> 6, tl = tid & 63;
  float* w1s = (float*)smem;
  float* w2s = w1s + 33 * 64;
  float* feats = w2s + 64 * 64;
  float* z1 = feats + 8 * 36;
  float* z2 = z1 + 8 * 64;
  const int l = it / 160, rem = it % 160;
  const float* w1 = pin(p, I_FW1) + l * 33 * 64;
  const float* b1 = pin(p, I_FB1) + l * 64;
  const float* w2 = pin(p, I_FW2) + l * 64 * 64;
  const float* b2 = pin(p, I_FB2) + l * 64;
  const float* w3 = pin(p, I_FW3) + l * 64 * 256;
  const float* b3 = pin(p, I_FB3) + l * 256;
  const float frq = pin(p, I_FFR)[l * 64 + tl];
  float* filt = (float*)(pws(p, OFF_FILT)) + (size_t)l * 1280 * 256;
  __syncthreads();
  for (int i = tid; i < 33 * 64; i += 256) w1s[i] = w1[i];
  for (int i = tid; i < 64 * 64; i += 256) w2s[i] = w2[i];
  int pidx[2], Lp[2], pos[2];
#pragma unroll
  for (int u = 0; u < 2; ++u) {
    pidx[u] = rem * 8 + q + 4 * u;
    Lp[u] = pidx[u] < 256 ? 256 : 1024;
    pos[u] = pidx[u] < 256 ? pidx[u] : pidx[u] - 256;
    if (tl < 33) {
      float f;
      if (tl == 0) f = (float)pos[u] / (float)(Lp[u] - 1);
      else {
        int j = (tl - 1) & 15;
        float fj = 1e-4f + (float)j * ((15.0f - 1e-4f) / 15.0f);
        float ang = (6.283185307179586f / (float)Lp[u]) * (float)pos[u] * fj;
        f = (tl <= 16) ? cosf(ang) : -sinf(ang);
      }
      feats[(q + 4 * u) * 36 + tl] = f;
    }
  }
  __syncthreads();
  {
    float s0 = b1[tl], s1 = s0;
#pragma unroll 3
    for (int j = 0; j < 33; ++j) {
      float w = w1s[j * 64 + tl];
      s0 += feats[q * 36 + j] * w;
      s1 += feats[(q + 4) * 36 + j] * w;
    }
    z1[q * 64 + tl] = sinf(frq * s0);
    z1[(q + 4) * 64 + tl] = sinf(frq * s1);
  }
  __syncthreads();
  {
    float s0 = b2[tl], s1 = s0;
#pragma unroll 4
    for (int j = 0; j < 64; ++j) {
      float w = w2s[j * 64 + tl];
      s0 += z1[q * 64 + j] * w;
      s1 += z1[(q + 4) * 64 + j] * w;
    }
    z2[q * 64 + tl] = sinf(frq * s0);
    z2[(q + 4) * 64 + tl] = sinf(frq * s1);
  }
  __syncthreads();
  float dist[2];
#pragma unroll
  for (int u = 0; u < 2; ++u) {
    const int centre = Lp[u] / 2;
    dist[u] = fabsf((float)(pos[u] - centre)) / (float)centre;
  }
#pragma unroll 1
  for (int cc = 0; cc < 4; ++cc) {
    const int c = tl + 64 * cc;
    float s0 = b3[c], s1 = s0;
#pragma unroll 1
    for (int j0 = 0; j0 < 64; j0 += 16) {
      float w[16];
#pragma unroll
      for (int j = 0; j < 16; ++j) w[j] = w3[(j0 + j) * 256 + c];
#pragma unroll
      for (int j = 0; j < 16; ++j) {
        s0 += z2[q * 64 + j0 + j] * w[j];
        s1 += z2[(q + 4) * 64 + j0 + j] * w[j];
      }
    }
    const float a = -3.0701134573253944f, b = -15.350567286626972f;
    const float delta = fabsf(a + (float)c * ((b - a) / 255.0f));
    filt[(size_t)pidx[0] * 256 + c] = s0 * expf(-dist[0] * delta);
    filt[(size_t)pidx[1] * 256 + c] = s1 * expf(-dist[1] * delta);
  }
}

struct ConvT {
  const float* src;
  bf16_t* dst;
  int K, N, k0, n0, gu;
};
DI ConvT conv_decode(const Params& p, int l, int idx) {
  bf16_t* wt = (bf16_t*)(pws(p, OFF_WT));
  int t = idx, which, K, N, nNt, gu;
  size_t dsto;
  if (t < 704) { which = I_W1G; K = DM; N = DFF; nNt = 44; dsto = WT_GU1; gu = 1; }
  else if ((t -= 704) < 704) { which = I_W1U; K = DM; N = DFF; nNt = 44; dsto = WT_GU1; gu = 2; }
  else if ((t -= 704) < 704) { which = I_W1D; K = DFF; N = DM; nNt = 16; dsto = WT_D1; gu = 0; }
  else if ((t -= 704) < 720) { which = I_WIN; K = DM; N = NIN; nNt = 45; dsto = WT_IN; gu = 0; }
  else if ((t -= 720) < 256) { which = I_WOUT; K = DM; N = DM; nNt = 16; dsto = WT_OUT; gu = 0; }
  else if ((t -= 256) < 704) { which = I_W2G; K = DM; N = DFF; nNt = 44; dsto = WT_GU2; gu = 1; }
  else if ((t -= 704) < 704) { which = I_W2U; K = DM; N = DFF; nNt = 44; dsto = WT_GU2; gu = 2; }
  else { t -= 704; which = I_W2D; K = DFF; N = DM; nNt = 16; dsto = WT_D2; gu = 0; }
  ConvT c;
  c.src = pin(p, which) + (size_t)l * K * N;
  c.dst = wt + dsto;
  c.K = K; c.N = N; c.k0 = (t / nNt) * 64; c.n0 = (t % nNt) * 64; c.gu = gu;
  return c;
}
DI void conv_load(const ConvT& c, int tid, float4 v[4]) {
#pragma unroll
  for (int i = 0; i < 4; ++i) {
    int r = (tid >> 4) + 16 * i, c4 = (tid & 15) * 4;
    v[i] = make_float4(0.f, 0.f, 0.f, 0.f);
    if (c.n0 + c4 < c.N) v[i] = *(const float4*)(c.src + (size_t)(c.k0 + r) * c.N + c.n0 + c4);
  }
}
DI void convert_layer(const Params& p, int l, char* smem) {
  const int tid = otid();
  float* tile = (float*)smem;
  int idx = obid();
  if (idx >= 5200) return;
  ConvT cur = conv_decode(p, l, idx);
  float4 v[4];
  conv_load(cur, tid, v);
  while (true) {
    __syncthreads();
#pragma unroll
    for (int i = 0; i < 4; ++i) {
      int r = (tid >> 4) + 16 * i, c4 = (tid & 15) * 4;
      tile[r * 65 + c4 + 0] = v[i].x; tile[r * 65 + c4 + 1] = v[i].y; tile[r * 65 + c4 + 2] = v[i].z; tile[r * 65 + c4 + 3] = v[i].w;
    }
    const int nxt = idx + gridDim.x;
    ConvT nx = cur;
    if (nxt < 5200) {
      nx = conv_decode(p, l, nxt);
      conv_load(nx, tid, v);
    }
    __syncthreads();
    const int n = tid >> 2, kq = tid & 3;
    if (cur.n0 + n < cur.N) {
      int nn = cur.n0 + n;
      int drow = (cur.gu == 0) ? nn : ((nn >> 5) * 64 + (cur.gu - 1) * 32 + (nn & 31));
      unsigned pk[8];
#pragma unroll
      for (int i = 0; i < 8; ++i)
        pk[i] = pack2(tile[(kq * 16 + 2 * i) * 65 + n], tile[(kq * 16 + 2 * i + 1) * 65 + n]);
      uint4* d = (uint4*)(cur.dst + (size_t)drow * cur.K + cur.k0 + kq * 16);
      d[0] = make_uint4(pk[0], pk[1], pk[2], pk[3]);
      d[1] = make_uint4(pk[4], pk[5], pk[6], pk[7]);
    }
    if (nxt >= 5200) break;
    idx = nxt;
    cur = nx;
  }
}

DI void phase_prologue(const Params& p, char* smem) {
  const int nb = gridDim.x, b = obid(), tid = otid();
  for (int it = b; it < 288; it += nb) mod_item(p, it, smem);
  for (int it = nb - 1 - b; it < 320; it += nb) filt_item(p, it, smem);
  {
    float* cosT = (float*)(pws(p, OFF_ROPE));
    float* sinT = cosT + 32768;
    for (int i = b * 256 + tid; i < 32768; i += nb * 256) {
      int t = i >> 5, e = i & 31;
      float pos = (e < 16) ? (float)(t >> 6) : (float)(t & 63);
      float inv = powf(10000.0f, -(float)(e & 15) / 16.0f);
      float ang = pos * inv;
      cosT[i] = cosf(ang);
      sinT[i] = sinf(ang);
    }
  }
  convert_layer(p, 0, smem);
}

DI void phase_norm(const Params& p, int l, bool from_input, const float* g, int part_shift, int part_scale) {
  const int lane = otid() & 63, wid = otid() >> 6;
  const float* modl = (const float*)(pws(p, OFF_MOD)) + (size_t)l * 5 * NMOD;
  bf16_t* H = (bf16_t*)(pws(p, OFF_H));
  const float* X = (const float*)(pws(p, OFF_X));
  for (int row = obid() * 4 + wid; row < NTOK; row += gridDim.x * 4) {
    const float* xr = from_input ? (row < NCTX ? pin(p, I_XP) + (size_t)row * DM : pin(p, I_XS) + (size_t)(row - NCTX) * DM)
                                 : X + (size_t)row * DM;
    float4 v[4];
    float ss = 0.f;
#pragma unroll
    for (int i = 0; i < 4; ++i) {
      v[i] = ((const float4*)xr)[lane + 64 * i];
      ss += v[i].x * v[i].x + v[i].y * v[i].y + v[i].z * v[i].z + v[i].w * v[i].w;
    }
    ss = wave_sum(ss);
    const float r = rsqrtf(ss * (1.0f / DM) + EPS);
    const float* mrow = modl + (size_t)mod_index(row) * NMOD;
#pragma unroll
    for (int i = 0; i < 4; ++i) {
      int c = 4 * (lane + 64 * i);
      float4 gg = *(const float4*)(g + c);
      float4 sc = *(const float4*)(mrow + part_scale * 1024 + c);
      float4 sh = *(const float4*)(mrow + part_shift * 1024 + c);
      float o0 = v[i].x * r * gg.x * (1.f + sc.x) + sh.x;
      float o1 = v[i].y * r * gg.y * (1.f + sc.y) + sh.y;
      float o2 = v[i].z * r * gg.z * (1.f + sc.z) + sh.z;
      float o3 = v[i].w * r * gg.w * (1.f + sc.w) + sh.w;
      *(uint2*)(H + (size_t)row * DM + c) = make_uint2(pack2(o0, o1), pack2(o2, o3));
    }
  }
}

DI void phase_final_norm(const Params& p) {
  const int lane = otid() & 63, wid = otid() >> 6;
  const float* X = (const float*)(pws(p, OFF_X));
  const float* g = pin(p, I_GFIN);
  for (int row = obid() * 4 + wid; row < NTOK; row += gridDim.x * 4) {
    const float* xr = X + (size_t)row * DM;
    float4 v[4];
    float ss = 0.f;
#pragma unroll
    for (int i = 0; i < 4; ++i) {
      v[i] = ((const float4*)xr)[lane + 64 * i];
      ss += v[i].x * v[i].x + v[i].y * v[i].y + v[i].z * v[i].z + v[i].w * v[i].w;
    }
    ss = wave_sum(ss);
    const float r = rsqrtf(ss * (1.0f / DM) + EPS);
#pragma unroll
    for (int i = 0; i < 4; ++i) {
      int c = 4 * (lane + 64 * i);
      float4 gg = *(const float4*)(g + c);
      float4 o = make_float4(v[i].x * r * gg.x, v[i].y * r * gg.y, v[i].z * r * gg.z, v[i].w * r * gg.w);
      *(float4*)(pout(p) + O_Y + (size_t)row * DM + c) = o;
    }
  }
}

enum { EPI_GU = 0, EPI_RES = 1, EPI_U = 2 };
struct EpiArgs {
  void* out;
  const float* xin0;
  const float* xin1;
  const float* modp;
  float coef;
};

using f32x16 = __attribute__((ext_vector_type(16))) float;
#define MFMA32(a, b, c) __builtin_amdgcn_mfma_f32_32x32x16_bf16((a), (b), (c), 0, 0, 0)

template <int EPI>
DI void gemm_phase(const bf16_t* __restrict__ A, int lda, const bf16_t* __restrict__ Bt, int ldb, int M, int N, int K,
                   const EpiArgs ea, char* smem, int tile_lo = 0, int tile_hi = 1 << 30) {
  const int tid = otid(), lane = tid & 63, r32 = lane & 31, h = lane >> 5;
  const int wid = __builtin_amdgcn_readfirstlane(tid >> 6);
  const int wn = wid & 1, kh = wid >> 1;
  const int nM = M / 128, nN = (N + 127) / 128, ntiles = (nM * nN < tile_hi) ? nM * nN : tile_hi, nk = K / 32;
  const int lrow = tid >> 2;
  const int lkc = ((tid & 3) ^ ((tid >> 4) & 3)) * 8;
  const int fsw = ((kh * 2 + h) ^ ((r32 >> 2) & 3)) * 16;
  const int aoff = r32 * 64 + fsw;
  const int aoffk = aoff + kh * 4096, aoffg = aoff + (1 - kh) * 4096;
  const int boff = 8192 + (wn * 64 + r32) * 64 + fsw;
#define GEMM_ISSUE(kt_)                                                                                              \
  do {                                                                                                               \
    char* st_ = smem + ((kt_) & 3) * 16384 + wid * 1024;                                                             \
    const unsigned ko_ = (unsigned)(kt_) * 64u;                                                                      \
    __builtin_amdgcn_global_load_lds((const unsigned*)((const char*)A + (ao0 + ko_)), (unsigned*)(st_), 16, 0, 0);   \
    __builtin_amdgcn_global_load_lds((const unsigned*)((const char*)A + (ao1 + ko_)), (unsigned*)(st_ + 4096), 16, 0, 0); \
    __builtin_amdgcn_global_load_lds((const unsigned*)((const char*)Bt + (bo0 + ko_)), (unsigned*)(st_ + 8192), 16, 0, 0); \
    __builtin_amdgcn_global_load_lds((const unsigned*)((const char*)Bt + (bo1 + ko_)), (unsigned*)(st_ + 12288), 16, 0, 0); \
  } while (0)
#define GEMM_ADDR(tile_)                                                                                             \
  do {                                                                                                               \
    m0 = ((tile_) % nM) * 128;                                                                                       \
    n0 = ((tile_) / nM) * 128;                                                                                       \
    ao0 = (unsigned)((m0 + lrow) * lda + lkc) * 2u;                                                                  \
    ao1 = ao0 + (unsigned)(64 * lda) * 2u;                                                                           \
    int br0_ = n0 + lrow, br1_ = n0 + lrow + 64;                                                                     \
    br0_ = br0_ < N ? br0_ : N - 1;                                                                                  \
    br1_ = br1_ < N ? br1_ : N - 1;                                                                                  \
    bo0 = (unsigned)(br0_ * ldb + lkc) * 2u;                                                                         \
    bo1 = (unsigned)(br1_ * ldb + lkc) * 2u;                                                                         \
  } while (0)
  int tile = tile_lo + obid();
  int m0 = 0, n0 = 0;
  unsigned ao0 = 0, ao1 = 0, bo0 = 0, bo1 = 0;
  if (tile < ntiles) {
    GEMM_ADDR(tile);
    GEMM_ISSUE(0);
    GEMM_ISSUE(1);
    GEMM_ISSUE(2);
  }
  while (tile < ntiles) {
    f32x16 acc[4][2];
#pragma unroll
    for (int i = 0; i < 4; ++i)
#pragma unroll
      for (int j = 0; j < 2; ++j)
#pragma unroll
        for (int r = 0; r < 16; ++r) acc[i][j][r] = 0.f;
    for (int kt = 0; kt < nk; ++kt) {
      if (kt + 2 < nk) asm volatile("s_waitcnt vmcnt(8)" ::: "memory");
      else if (kt + 1 < nk) asm volatile("s_waitcnt vmcnt(4)" ::: "memory");
      else asm volatile("s_waitcnt vmcnt(0)" ::: "memory");
      asm volatile("s_waitcnt lgkmcnt(0)" ::: "memory");
      __builtin_amdgcn_s_barrier();
      if (kt + 3 < nk) GEMM_ISSUE(kt + 3);
      const char* st = smem + (kt & 3) * 16384;
      bf16x8 af[4], bfr[2];
#pragma unroll
      for (int i = 0; i < 4; ++i) af[i] = *(const bf16x8*)(st + ((i < 2) ? aoffk : aoffg) + (i & 1) * 2048);
#pragma unroll
      for (int j = 0; j < 2; ++j) bfr[j] = *(const bf16x8*)(st + boff + j * 2048);
#pragma unroll
      for (int i = 0; i < 4; ++i)
#pragma unroll
        for (int j = 0; j < 2; ++j) acc[i][j] = MFMA32(af[i], bfr[j], acc[i][j]);
    }
    asm volatile("s_waitcnt lgkmcnt(0)" ::: "memory");
    __builtin_amdgcn_s_barrier();
    {
      float* mine = (float*)(smem + wid * 16384);
      const float* theirs = (const float*)(smem + (wid ^ 2) * 16384);
#pragma unroll
      for (int i = 0; i < 2; ++i)
#pragma unroll
        for (int j = 0; j < 2; ++j)
#pragma unroll
          for (int r = 0; r < 16; ++r) mine[((i * 2 + j) * 16 + r) * 64 + lane] = acc[2 + i][j][r];
      __syncthreads();
#pragma unroll
      for (int i = 0; i < 2; ++i)
#pragma unroll
        for (int j = 0; j < 2; ++j) {
#pragma unroll
          for (int r = 0; r < 16; ++r) acc[i][j][r] += theirs[((i * 2 + j) * 16 + r) * 64 + lane];
          asm volatile("" ::: "memory");
        }
      asm volatile("s_waitcnt lgkmcnt(0)" ::: "memory");
      __builtin_amdgcn_s_barrier();
    }
    const int em0 = m0, en0 = n0;
    tile += gridDim.x;
    if (tile < ntiles) {
      GEMM_ADDR(tile);
      GEMM_ISSUE(0);
      GEMM_ISSUE(1);
      GEMM_ISSUE(2);
    }
    const int rbase = em0 + 2 * kh * 32 + 4 * h;
    if (EPI == EPI_GU) {
      bf16_t* act = (bf16_t*)ea.out + (size_t)rbase * DFF + ((en0 + wn * 64) >> 1) + r32;
#pragma unroll
      for (int mi = 0; mi < 2; ++mi)
#pragma unroll
        for (int rq = 0; rq < 4; ++rq) {
#pragma unroll
          for (int rr = 0; rr < 4; ++rr) {
            const int r = rq * 4 + rr;
            const float gt = acc[mi][0][r], up = acc[mi][1][r];
            act[(size_t)(mi * 32 + rr + 8 * rq) * DFF] = f2bf(gt / (1.f + __expf(-gt)) * up);
          }
          asm volatile("" ::: "memory");
        }
    } else if (EPI == EPI_RES) {
      float* X = (float*)ea.out + (size_t)rbase * DM + en0 + wn * 64 + r32;
      const float* xr = (em0 < NCTX ? ea.xin0 + (size_t)rbase * DM : ea.xin1 + (size_t)(rbase - NCTX) * DM) + en0 + wn * 64 + r32;
      const float* mr = ea.modp + (size_t)mod_index(em0) * NMOD + en0 + wn * 64 + r32;
      const float g0 = ea.coef * mr[0], g1 = ea.coef * mr[32];
#pragma unroll
      for (int mi = 0; mi < 2; ++mi)
#pragma unroll
        for (int rq = 0; rq < 4; ++rq) {
#pragma unroll
          for (int rr = 0; rr < 4; ++rr) {
            const int r = rq * 4 + rr;
            const size_t ro = (size_t)(mi * 32 + rr + 8 * rq) * DM;
            const float x0 = xr[ro], x1 = xr[ro + 32];
            X[ro] = x0 + g0 * acc[mi][0][r];
            X[ro + 32] = x1 + g1 * acc[mi][1][r];
          }
          asm volatile("" ::: "memory");
        }
    } else {
      float* U = (float*)ea.out + (size_t)rbase * NIN + en0 + wn * 64 + r32;
      const bool ok0 = en0 + wn * 64 + r32 < N, ok1 = en0 + wn * 64 + 32 + r32 < N;
#pragma unroll
      for (int mi = 0; mi < 2; ++mi)
#pragma unroll
        for (int rq = 0; rq < 4; ++rq) {
#pragma unroll
          for (int rr = 0; rr < 4; ++rr) {
            const int r = rq * 4 + rr;
            const size_t ro = (size_t)(mi * 32 + rr + 8 * rq) * NIN;
            if (ok0) U[ro] = acc[mi][0][r];
            if (ok1) U[ro + 32] = acc[mi][1][r];
          }
          asm volatile("" ::: "memory");
        }
    }
    asm volatile("s_waitcnt vmcnt(0)" ::: "memory");
  }
#undef GEMM_ISSUE
#undef GEMM_ADDR
}

template <int EPI>
DI void gemm_k64(const bf16_t* __restrict__ A, int lda, const bf16_t* __restrict__ Bt, int ldb, int M, int N, int K,
                   const EpiArgs ea, char* smem, int tile_lo = 0, int tile_hi = 1 << 30) {
  const int tid = otid(), lane = tid & 63, r32 = lane & 31, h = lane >> 5;
  const int wid = __builtin_amdgcn_readfirstlane(tid >> 6);
  const int wn = wid & 1, kh = wid >> 1;
  const int nM = M / 128, nN = (N + 127) / 128, ntiles = (nM * nN < tile_hi) ? nM * nN : tile_hi, nk = K / 64;
  const int lrow = tid >> 3;
  const int lkc = ((tid & 7) ^ ((tid >> 4) & 7)) * 8;
  const int fsw0 = ((kh * 4 + h) ^ ((r32 >> 1) & 7)) * 16, fsw1 = ((kh * 4 + 2 + h) ^ ((r32 >> 1) & 7)) * 16;
  const int aoffk = r32 * 128 + kh * 8192, aoffg = r32 * 128 + (1 - kh) * 8192;
  const int boff = 16384 + (wn * 64 + r32) * 128;
#define GEMM_ISSUE(kt_)                                                                                              \
  do {                                                                                                               \
    char* st_ = smem + ((kt_) & 1) * 32768 + wid * 1024;                                                             \
    const unsigned ko_ = (unsigned)(kt_) * 128u;                                                                     \
    _Pragma("unroll") for (int i_ = 0; i_ < 4; ++i_)                                                                 \
      __builtin_amdgcn_global_load_lds((const unsigned*)((const char*)A + (ao0 + i_ * ao32 + ko_)),                  \
                                       (unsigned*)(st_ + i_ * 4096), 16, 0, 0);                                      \
    _Pragma("unroll") for (int i_ = 0; i_ < 4; ++i_)                                                                 \
      __builtin_amdgcn_global_load_lds((const unsigned*)((const char*)Bt + (bo[i_] + ko_)),                          \
                                       (unsigned*)(st_ + 16384 + i_ * 4096), 16, 0, 0);                              \
  } while (0)
#define GEMM_ADDR(tile_)                                                                                             \
  do {                                                                                                               \
    m0 = ((tile_) % nM) * 128;                                                                                       \
    n0 = ((tile_) / nM) * 128;                                                                                       \
    ao0 = (unsigned)((m0 + lrow) * lda + lkc) * 2u;                                                                  \
    _Pragma("unroll") for (int i_ = 0; i_ < 4; ++i_) {                                                               \
      int br_ = n0 + lrow + 32 * i_;                                                                                 \
      br_ = br_ < N ? br_ : N - 1;                                                                                   \
      bo[i_] = (unsigned)(br_ * ldb + lkc) * 2u;                                                                     \
    }                                                                                                                \
  } while (0)
  const unsigned ao32 = (unsigned)(32 * lda) * 2u;
  int tile = tile_lo + obid();
  int m0 = 0, n0 = 0;
  unsigned ao0 = 0, bo[4] = {0, 0, 0, 0};
  if (tile < ntiles) {
    GEMM_ADDR(tile);
    GEMM_ISSUE(0);
  }
  while (tile < ntiles) {
    f32x16 acc[4][2];
#pragma unroll
    for (int i = 0; i < 4; ++i)
#pragma unroll
      for (int j = 0; j < 2; ++j)
#pragma unroll
        for (int r = 0; r < 16; ++r) acc[i][j][r] = 0.f;
    for (int kt = 0; kt < nk; ++kt) {
      asm volatile("s_waitcnt vmcnt(0)" ::: "memory");
      asm volatile("s_waitcnt lgkmcnt(0)" ::: "memory");
      __builtin_amdgcn_s_barrier();
      if (kt + 1 < nk) GEMM_ISSUE(kt + 1);
      const char* st = smem + (kt & 1) * 32768;
#pragma unroll
      for (int ks = 0; ks < 2; ++ks) {
        const int fsw = ks ? fsw1 : fsw0;
        bf16x8 af[4], bfr[2];
#pragma unroll
        for (int i = 0; i < 4; ++i) af[i] = *(const bf16x8*)(st + ((i < 2) ? aoffk : aoffg) + (i & 1) * 4096 + fsw);
#pragma unroll
        for (int j = 0; j < 2; ++j) bfr[j] = *(const bf16x8*)(st + boff + j * 4096 + fsw);
#pragma unroll
        for (int i = 0; i < 4; ++i)
#pragma unroll
          for (int j = 0; j < 2; ++j) acc[i][j] = MFMA32(af[i], bfr[j], acc[i][j]);
      }
    }
    asm volatile("s_waitcnt lgkmcnt(0)" ::: "memory");
    __builtin_amdgcn_s_barrier();
    {
      float* mine = (float*)(smem + wid * 16384);
      const float* theirs = (const float*)(smem + (wid ^ 2) * 16384);
#pragma unroll
      for (int i = 0; i < 2; ++i)
#pragma unroll
        for (int j = 0; j < 2; ++j)
#pragma unroll
          for (int r = 0; r < 16; ++r) mine[((i * 2 + j) * 16 + r) * 64 + lane] = acc[2 + i][j][r];
      __syncthreads();
#pragma unroll
      for (int i = 0; i < 2; ++i)
#pragma unroll
        for (int j = 0; j < 2; ++j) {
#pragma unroll
          for (int r = 0; r < 16; ++r) acc[i][j][r] += theirs[((i * 2 + j) * 16 + r) * 64 + lane];
          asm volatile("" ::: "memory");
        }
      asm volatile("s_waitcnt lgkmcnt(0)" ::: "memory");
      __builtin_amdgcn_s_barrier();
    }
    const int em0 = m0, en0 = n0;
    tile += gridDim.x;
    if (tile < ntiles) {
      GEMM_ADDR(tile);
      GEMM_ISSUE(0);
    }
    const int rbase = em0 + 2 * kh * 32 + 4 * h;
    if (EPI == EPI_GU) {
      bf16_t* act = (bf16_t*)ea.out + (size_t)rbase * DFF + ((en0 + wn * 64) >> 1) + r32;
#pragma unroll
      for (int mi = 0; mi < 2; ++mi)
#pragma unroll
        for (int rq = 0; rq < 4; ++rq) {
#pragma unroll
          for (int rr = 0; rr < 4; ++rr) {
            const int r = rq * 4 + rr;
            const float gt = acc[mi][0][r], up = acc[mi][1][r];
            act[(size_t)(mi * 32 + rr + 8 * rq) * DFF] = f2bf(gt / (1.f + __expf(-gt)) * up);
          }
          asm volatile("" ::: "memory");
        }
    } else if (EPI == EPI_RES) {
      float* X = (float*)ea.out + (size_t)rbase * DM + en0 + wn * 64 + r32;
      const float* xr = (em0 < NCTX ? ea.xin0 + (size_t)rbase * DM : ea.xin1 + (size_t)(rbase - NCTX) * DM) + en0 + wn * 64 + r32;
      const float* mr = ea.modp + (size_t)mod_index(em0) * NMOD + en0 + wn * 64 + r32;
      const float g0 = ea.coef * mr[0], g1 = ea.coef * mr[32];
#pragma unroll
      for (int mi = 0; mi < 2; ++mi)
#pragma unroll
        for (int rq = 0; rq < 4; ++rq) {
#pragma unroll
          for (int rr = 0; rr < 4; ++rr) {
            const int r = rq * 4 + rr;
            const size_t ro = (size_t)(mi * 32 + rr + 8 * rq) * DM;
            const float x0 = xr[ro], x1 = xr[ro + 32];
            X[ro] = x0 + g0 * acc[mi][0][r];
            X[ro + 32] = x1 + g1 * acc[mi][1][r];
          }
          asm volatile("" ::: "memory");
        }
    } else {
      float* U = (float*)ea.out + (size_t)rbase * NIN + en0 + wn * 64 + r32;
      const bool ok0 = en0 + wn * 64 + r32 < N, ok1 = en0 + wn * 64 + 32 + r32 < N;
#pragma unroll
      for (int mi = 0; mi < 2; ++mi)
#pragma unroll
        for (int rq = 0; rq < 4; ++rq) {
#pragma unroll
          for (int rr = 0; rr < 4; ++rr) {
            const int r = rq * 4 + rr;
            const size_t ro = (size_t)(mi * 32 + rr + 8 * rq) * NIN;
            if (ok0) U[ro] = acc[mi][0][r];
            if (ok1) U[ro + 32] = acc[mi][1][r];
          }
          asm volatile("" ::: "memory");
        }
    }
    asm volatile("s_waitcnt vmcnt(0)" ::: "memory");
  }
#undef GEMM_ISSUE
#undef GEMM_ADDR
}

template <int EPI>
DI void gemm_big(const bf16_t* __restrict__ A, int lda, const bf16_t* __restrict__ Bt, int ldb, int M, int N, int K,
                 const EpiArgs ea, char* smem, int tile_hi = 1 << 30) {
  const int tid = otid(), lane = tid & 63, r32 = lane & 31, h = lane >> 5;
  const int wid = __builtin_amdgcn_readfirstlane(tid >> 6);
  const int wm = wid >> 1, wn = wid & 1;
  const int nM = M / 256, nN = N / 128, ntiles = (nM * nN < tile_hi) ? nM * nN : tile_hi, nk = K / 32;
  const int lrow = tid >> 2;
  const int lkc = ((tid & 3) ^ ((tid >> 4) & 3)) * 8;
  const int sw0 = ((0 + h) ^ ((r32 >> 2) & 3)) * 16, sw1 = ((2 + h) ^ ((r32 >> 2) & 3)) * 16;
  const int arow = (wm * 128 + r32) * 64;
  const int brow = 16384 + (wn * 64 + r32) * 64;
#define BIG_ISSUE(kt_, st_i)                                                                                         \
  do {                                                                                                               \
    char* st_ = smem + (st_i) * 24576 + wid * 1024;                                                                  \
    const unsigned ko_ = (unsigned)(kt_) * 64u;                                                                      \
    __builtin_amdgcn_global_load_lds((const unsigned*)((const char*)A + (ao0 + ko_)), (unsigned*)(st_), 16, 0, 0);   \
    __builtin_amdgcn_global_load_lds((const unsigned*)((const char*)A + (ao0 + ao64 + ko_)), (unsigned*)(st_ + 4096), 16, 0, 0); \
    __builtin_amdgcn_global_load_lds((const unsigned*)((const char*)A + (ao0 + 2 * ao64 + ko_)), (unsigned*)(st_ + 8192), 16, 0, 0); \
    __builtin_amdgcn_global_load_lds((const unsigned*)((const char*)A + (ao0 + 3 * ao64 + ko_)), (unsigned*)(st_ + 12288), 16, 0, 0); \
    __builtin_amdgcn_global_load_lds((const unsigned*)((const char*)Bt + (bo0 + ko_)), (unsigned*)(st_ + 16384), 16, 0, 0); \
    __builtin_amdgcn_global_load_lds((const unsigned*)((const char*)Bt + (bo0 + bo64 + ko_)), (unsigned*)(st_ + 20480), 16, 0, 0); \
  } while (0)
#define BIG_ADDR(tile_)                                                                                              \
  do {                                                                                                               \
    m0 = ((tile_) % nM) * 256;                                                                                       \
    n0 = ((tile_) / nM) * 128;                                                                                       \
    ao0 = (unsigned)((m0 + lrow) * lda + lkc) * 2u;                                                                  \
    bo0 = (unsigned)((n0 + lrow) * ldb + lkc) * 2u;                                                                  \
  } while (0)
  const unsigned ao64 = (unsigned)(64 * lda) * 2u, bo64 = (unsigned)(64 * ldb) * 2u;
  int tile = obid();
  int m0 = 0, n0 = 0;
  unsigned ao0 = 0, bo0 = 0;
  if (tile < ntiles) {
    BIG_ADDR(tile);
    BIG_ISSUE(0, 0);
    BIG_ISSUE(1, 1);
  }
  while (tile < ntiles) {
    f32x16 acc[4][2];
#pragma unroll
    for (int i = 0; i < 4; ++i)
#pragma unroll
      for (int j = 0; j < 2; ++j)
#pragma unroll
        for (int r = 0; r < 16; ++r) acc[i][j][r] = 0.f;
    int sc = 0;
    for (int kt = 0; kt < nk; ++kt) {
      if (kt + 1 < nk) asm volatile("s_waitcnt vmcnt(6)" ::: "memory");
      else asm volatile("s_waitcnt vmcnt(0)" ::: "memory");
      asm volatile("s_waitcnt lgkmcnt(0)" ::: "memory");
      __builtin_amdgcn_s_barrier();
      if (kt + 2 < nk) {
        const int sn = sc == 0 ? 2 : sc - 1;
        BIG_ISSUE(kt + 2, sn);
      }
      const char* st = smem + sc * 24576;
      {
        bf16x8 af[4], bfr[2];
#pragma unroll
        for (int i = 0; i < 4; ++i) af[i] = *(const bf16x8*)(st + arow + i * 2048 + sw0);
#pragma unroll
        for (int j = 0; j < 2; ++j) bfr[j] = *(const bf16x8*)(st + brow + j * 2048 + sw0);
#pragma unroll
        for (int i = 0; i < 4; ++i)
#pragma unroll
          for (int j = 0; j < 2; ++j) acc[i][j] = MFMA32(af[i], bfr[j], acc[i][j]);
      }
      {
        bf16x8 af[4], bfr[2];
#pragma unroll
        for (int i = 0; i < 4; ++i) af[i] = *(const bf16x8*)(st + arow + i * 2048 + sw1);
#pragma unroll
        for (int j = 0; j < 2; ++j) bfr[j] = *(const bf16x8*)(st + brow + j * 2048 + sw1);
#pragma unroll
        for (int i = 0; i < 4; ++i)
#pragma unroll
          for (int j = 0; j < 2; ++j) acc[i][j] = MFMA32(af[i], bfr[j], acc[i][j]);
      }
      sc = sc == 2 ? 0 : sc + 1;
    }
    asm volatile("s_waitcnt lgkmcnt(0)" ::: "memory");
    __builtin_amdgcn_s_barrier();
    const int em0 = m0, en0 = n0;
    tile += gridDim.x;
    if (tile < ntiles) {
      BIG_ADDR(tile);
      BIG_ISSUE(0, 0);
      BIG_ISSUE(1, 1);
    }
    const int rbase = em0 + wm * 128 + 4 * h;
    if (EPI == EPI_GU) {
      bf16_t* act = (bf16_t*)ea.out + (size_t)rbase * DFF + ((en0 + wn * 64) >> 1) + r32;
#pragma unroll
      for (int mt = 0; mt < 4; ++mt)
#pragma unroll
        for (int rq = 0; rq < 4; ++rq) {
#pragma unroll
          for (int rr = 0; rr < 4; ++rr) {
            const int r = rq * 4 + rr;
            const float gt = acc[mt][0][r], up = acc[mt][1][r];
            act[(size_t)(mt * 32 + rr + 8 * rq) * DFF] = f2bf(gt / (1.f + __expf(-gt)) * up);
          }
          asm volatile("" ::: "memory");
        }
    } else {
      float* X = (float*)ea.out + (size_t)rbase * DM + en0 + wn * 64 + r32;
      const float* xr = (em0 < NCTX ? ea.xin0 + (size_t)rbase * DM : ea.xin1 + (size_t)(rbase - NCTX) * DM) + en0 + wn * 64 + r32;
      const float* mr = ea.modp + (size_t)mod_index(em0) * NMOD + en0 + wn * 64 + r32;
      const float g0 = ea.coef * mr[0], g1 = ea.coef * mr[32];
#pragma unroll
      for (int mt = 0; mt < 4; ++mt)
#pragma unroll
        for (int rq = 0; rq < 4; ++rq) {
#pragma unroll
          for (int rr = 0; rr < 4; ++rr) {
            const int r = rq * 4 + rr;
            const size_t ro = (size_t)(mt * 32 + rr + 8 * rq) * DM;
            const float x0 = xr[ro], x1 = xr[ro + 32];
            X[ro] = x0 + g0 * acc[mt][0][r];
            X[ro + 32] = x1 + g1 * acc[mt][1][r];
          }
          asm volatile("" ::: "memory");
        }
    }
    asm volatile("s_waitcnt vmcnt(0)" ::: "memory");
  }
#undef BIG_ISSUE
#undef BIG_ADDR
}

DI int key_row(int t) { return t < NCTX ? t : NCTX + ((t - NCTX) >> 10) * 1280 + 256 + ((t - NCTX) & 1023); }

DI void phase_prep(const Params& p, int l) {
  const int tid = otid();
  const float* U = (const float*)(pws(p, OFF_U));
  bf16_t* QB = (bf16_t*)(pws(p, OFF_QB));
  bf16_t* QC = (bf16_t*)(pws(p, OFF_QC));
  bf16_t* KB = (bf16_t*)(pws(p, OFF_KB));
  bf16_t* VB = (bf16_t*)(pws(p, OFF_VB));
  bf16_t* KC = (bf16_t*)(pws(p, OFF_KC));
  bf16_t* VC = (bf16_t*)(pws(p, OFF_VC));
  const float* cosT = (const float*)(pws(p, OFF_ROPE));
  const float* sinT = cosT + 32768;
  const float* gq = pin(p, I_GQN) + l * 64;
  const float* gk = pin(p, I_GKN) + l * 64;
  const int gid = (obid() * 256 + tid) >> 4, ngroups = gridDim.x * 16, i16 = tid & 15;
  const int nunits = NTOK * 16;
  for (int base = 0; base < nunits; base += ngroups) {
    int unit = base + gid;
    const bool valid = unit < nunits;
    if (!valid) unit = nunits - 1;
    const int t = unit >> 4, hv = unit & 15;
    int col;
    if (hv < 4) col = 1040 + hv * 64;
    else if (hv < 6) col = 1296 + (hv - 4) * 64;
    else if (hv < 8) col = 1424 + (hv - 6) * 64;
    else if (hv < 12) col = 1552 + (hv - 8) * 64;
    else if (hv < 14) col = 1808 + (hv - 12) * 64;
    else col = 1936 + (hv - 14) * 64;
    float4 xv = *(const float4*)(U + (size_t)t * NIN + col + i16 * 4);
    float x[4] = {xv.x, xv.y, xv.z, xv.w};
    const bool lat = t >= NCTX;
    const bool do_norm = hv < 6;
    const bool is_q = (hv < 4) || (hv >= 8 && hv < 12);
    const bool is_v = (hv == 6 || hv == 7 || hv >= 14);
    float ss = x[0] * x[0] + x[1] * x[1] + x[2] * x[2] + x[3] * x[3];
    ss += shx<1>(ss); ss += shx<2>(ss); ss += shx<4>(ss); ss += shx<8>(ss);
    if (do_norm) {
      const float r = rsqrtf(ss * (1.0f / 64.0f) + EPS);
      const float* gg = (hv < 4) ? gq : gk;
#pragma unroll
      for (int j = 0; j < 4; ++j) x[j] = x[j] * r * gg[i16 * 4 + j];
    }
    if (!lat && valid && !is_q) {
      const int b = t >> 8, s = t & 255;
      size_t o;
      int kvh;
      if (hv < 6) { o = O_GK; kvh = hv - 4; }
      else if (hv < 8) { o = O_GV; kvh = hv - 6; }
      else if (hv < 14) { o = O_SK; kvh = hv - 12; }
      else { o = O_SV; kvh = hv - 14; }
      float* dst = pout(p) + o + ((size_t)((b * 2 + l) * 256 + s)) * 128 + kvh * 64 + i16 * 4;
      *(float4*)dst = make_float4(x[0], x[1], x[2], x[3]);
    }
    float xp[4];
#pragma unroll
    for (int j = 0; j < 4; ++j) xp[j] = shx<4>(x[j]);
    if (lat && !is_v) {
      const int s = (t - NCTX) & 1023;
      const bool first = (i16 & 4) == 0;
#pragma unroll
      for (int j = 0; j < 4; ++j) {
        int d = i16 * 4 + j;
        int e = (d < 32) ? (d & 15) : 16 + (d & 15);
        float cs = cosT[s * 32 + e], sn = sinT[s * 32 + e];
        x[j] = first ? (x[j] * cs - xp[j] * sn) : (x[j] * cs + xp[j] * sn);
      }
    }
    if (is_q) {
#pragma unroll
      for (int j = 0; j < 4; ++j) x[j] *= 0.125f;
    }
    if (valid) {
      uint2 pk = make_uint2(pack2(x[0], x[1]), pack2(x[2], x[3]));
      bf16_t* dst;
      if (hv < 4) dst = QB + (size_t)t * 256 + hv * 64;
      else if (hv < 6) dst = KB + (size_t)key_row(t) * 128 + (hv - 4) * 64;
      else if (hv < 8) dst = VB + (size_t)key_row(t) * 128 + (hv - 6) * 64;
      else if (hv < 12) dst = QC + (size_t)t * 256 + (hv - 8) * 64;
      else if (hv < 14) dst = KC + (size_t)key_row(t) * 128 + (hv - 12) * 64;
      else dst = VC + (size_t)key_row(t) * 128 + (hv - 14) * 64;
      *(uint2*)(dst + i16 * 4) = pk;
    }
  }
  for (int i = obid() * 256 + tid; i < 4 * 4 * 256 * 32; i += gridDim.x * 256) {
    const int which = i >> 15, rem = i & 32767;
    const int b = rem >> 13, s = (rem >> 5) & 255, c4 = (rem & 31) * 4;
    const float* srcb = (which == 0) ? pin(p, I_CGK) : (which == 1) ? pin(p, I_CGV) : (which == 2) ? pin(p, I_CSK) : pin(p, I_CSV);
    const float* src = srcb + ((size_t)((b * 2 + l) * 256 + s)) * 128 + c4;
    float4 v = *(const float4*)src;
    bf16_t* dstb = (which == 0) ? KB : (which == 1) ? VB : (which == 2) ? KC : VC;
    *(uint2*)(dstb + (size_t)(NCTX + b * 1280 + s) * 128 + c4) = make_uint2(pack2(v.x, v.y), pack2(v.z, v.w));
  }
}

DI void attn_item(const bf16_t* Q, const bf16_t* K, const bf16_t* V, int q0, int n1, int start2, int n2, bool window,
                  bool has_sink, float sink, bf16_t* Y, char* smem) {
  const int tid = otid(), lane = tid & 63, wid = tid >> 6, g = lane >> 4, r16 = lane & 15;
  bf16_t* Ks = (bf16_t*)smem;
  bf16_t* Vt = Ks + 64 * 72;
  int qrow[2];
  bf16x8 qf[2][2];
  float m_run[2], l_run[2];
  f32x4 o[2][4];
#pragma unroll
  for (int u = 0; u < 2; ++u) {
    qrow[u] = q0 + wid * 32 + u * 16 + r16;
    qf[u][0] = *(const bf16x8*)(Q + (size_t)qrow[u] * 256 + g * 8);
    qf[u][1] = *(const bf16x8*)(Q + (size_t)qrow[u] * 256 + 32 + g * 8);
    m_run[u] = has_sink ? sink : -INFINITY;
    l_run[u] = (has_sink && g == 0) ? 1.f : 0.f;
#pragma unroll
    for (int i = 0; i < 4; ++i) o[u][i] = (f32x4){0.f, 0.f, 0.f, 0.f};
  }
  const int ntl = n1 + n2;
  uint4 pk[2], pv[2];
#pragma unroll
  for (int j = 0; j < 2; ++j) {
    int c = tid + 256 * j, key = c >> 3, dc = (c & 7) * 8;
    const int tile0 = n1 > 0 ? 0 : start2;
    pk[j] = *(const uint4*)(K + (size_t)(tile0 * 64 + key) * 128 + dc);
    pv[j] = *(const uint4*)(V + (size_t)(tile0 * 64 + key) * 128 + dc);
  }
  for (int ti = 0; ti < ntl; ++ti) {
    const int tile = ti < n1 ? ti : start2 + (ti - n1);
    __syncthreads();
#pragma unroll
    for (int j = 0; j < 2; ++j) {
      int c = tid + 256 * j, key = c >> 3, dc = (c & 7) * 8;
      uint4 kv = pk[j];
      *(uint4*)(Ks + key * 72 + dc) = kv;
      uint4 vv = pv[j];
      unsigned w[4] = {vv.x, vv.y, vv.z, vv.w};
#pragma unroll
      for (int i = 0; i < 4; ++i) {
        Vt[(dc + 2 * i) * 72 + key] = (bf16_t)(w[i] & 0xffffu);
        Vt[(dc + 2 * i + 1) * 72 + key] = (bf16_t)(w[i] >> 16);
      }
    }
    __syncthreads();
    if (ti + 1 < ntl) {
      const int tnext = (ti + 1) < n1 ? (ti + 1) : start2 + (ti + 1 - n1);
#pragma unroll
      for (int j = 0; j < 2; ++j) {
        int c = tid + 256 * j, key = c >> 3, dc = (c & 7) * 8;
        pk[j] = *(const uint4*)(K + (size_t)(tnext * 64 + key) * 128 + dc);
        pv[j] = *(const uint4*)(V + (size_t)(tnext * 64 + key) * 128 + dc);
      }
    }
    f32x4 s[2][4];
#pragma unroll
    for (int kt = 0; kt < 4; ++kt) {
      bf16x8 a0 = *(const bf16x8*)(Ks + (kt * 16 + r16) * 72 + g * 8);
      bf16x8 a1 = *(const bf16x8*)(Ks + (kt * 16 + r16) * 72 + 32 + g * 8);
#pragma unroll
      for (int u = 0; u < 2; ++u) {
        f32x4 z = (f32x4){0.f, 0.f, 0.f, 0.f};
        z = MFMA16(a0, qf[u][0], z);
        s[u][kt] = MFMA16(a1, qf[u][1], z);
      }
    }
    bf16x8 pb[2][2];
#pragma unroll
    for (int u = 0; u < 2; ++u) {
      if (window && tile >= 4) {
#pragma unroll
        for (int kt = 0; kt < 4; ++kt)
#pragma unroll
          for (int j = 0; j < 4; ++j) {
            int kp = (tile - 4) * 64 + kt * 16 + g * 4 + j;
            int dlt = kp - qrow[u];
            if (dlt > 128 || dlt < -128) s[u][kt][j] = -INFINITY;
          }
      }
      float mx = -INFINITY;
#pragma unroll
      for (int kt = 0; kt < 4; ++kt)
#pragma unroll
        for (int j = 0; j < 4; ++j) mx = fmaxf(mx, s[u][kt][j]);
      mx = fmaxf(mx, shx<16>(mx));
      mx = fmaxf(mx, __shfl_xor(mx, 32));
      const float m_new = fmaxf(m_run[u], mx);
      float alpha, msub;
      if (m_new == -INFINITY) { alpha = 1.f; msub = 0.f; }
      else { alpha = __expf(m_run[u] - m_new); msub = m_new; }
      float lsum = 0.f;
#pragma unroll
      for (int kt = 0; kt < 4; ++kt)
#pragma unroll
        for (int j = 0; j < 4; ++j) {
          float pe = __expf(s[u][kt][j] - msub);
          s[u][kt][j] = pe;
          lsum += pe;
        }
      l_run[u] = l_run[u] * alpha + lsum;
      m_run[u] = m_new;
#pragma unroll
      for (int i = 0; i < 4; ++i) o[u][i] *= alpha;
#pragma unroll
      for (int c = 0; c < 2; ++c) {
        unsigned* pw = (unsigned*)&pb[u][c];
        pw[0] = pack2(s[u][2 * c][0], s[u][2 * c][1]);
        pw[1] = pack2(s[u][2 * c][2], s[u][2 * c][3]);
        pw[2] = pack2(s[u][2 * c + 1][0], s[u][2 * c + 1][1]);
        pw[3] = pack2(s[u][2 * c + 1][2], s[u][2 * c + 1][3]);
      }
    }
#pragma unroll
    for (int c = 0; c < 2; ++c)
#pragma unroll
      for (int et = 0; et < 4; ++et) {
        const bf16_t* vp = Vt + (et * 16 + r16) * 72 + c * 32 + g * 4;
        bf16x4 lo = *(const bf16x4*)(vp);
        bf16x4 hi = *(const bf16x4*)(vp + 16);
        bf16x8 a = __builtin_shufflevector(lo, hi, 0, 1, 2, 3, 4, 5, 6, 7);
#pragma unroll
        for (int u = 0; u < 2; ++u) o[u][et] = MFMA16(a, pb[u][c], o[u][et]);
      }
  }
#pragma unroll
  for (int u = 0; u < 2; ++u) {
    float lt = l_run[u];
    lt += shx<16>(lt);
    lt += __shfl_xor(lt, 32);
    const float inv = 1.f / lt;
#pragma unroll
    for (int et = 0; et < 4; ++et) {
      uint2 pk2 = make_uint2(pack2(o[u][et][0] * inv, o[u][et][1] * inv), pack2(o[u][et][2] * inv, o[u][et][3] * inv));
      *(uint2*)(Y + (size_t)qrow[u] * DM + et * 16 + g * 4) = pk2;
    }
  }
}

using f32x2 = __attribute__((ext_vector_type(2))) float;
template <int NI>
DI void hyena_item(const Params& p, int l, int tok0, int cq, bf16_t* YM, char* smem) {
  constexpr int L = NI * 256;
  constexpr int NH = (NI >= 2) ? NI / 2 : 1;
  const int tid = otid(), lane = tid & 63;
  const int wid = __builtin_amdgcn_readfirstlane(tid >> 6);
  const int pr = wid & 1, hf = wid >> 1;
  const int c0 = cq * 4, ca = c0 + 2 * pr;
  f32x2* zz = (f32x2*)((float*)smem + pr * (8 * L));
  f32x2* h2 = zz + 2 * L;
  f32x2* x2 = h2 + L;
  float* raw = (float*)smem + 2 * (8 * L);
  const float* U = (const float*)(pws(p, OFF_U));
  const float* cw = pin(p, I_CW) + l * 3 * 768;
  const float* cb = pin(p, I_CB) + l * 768;
  const float* filt = (const float*)(pws(p, OFF_FILT)) + (size_t)l * 1280 * 256 + (size_t)(NI == 1 ? 0 : 256) * 256;
  f32x2 w0a, w0b, w0c, b0, w1a, w1b, w1c, b1, w2a, w2b, w2c, b2;
#pragma unroll
  for (int e = 0; e < 2; ++e) {
    const int c = ca + e;
    w0a[e] = cw[c]; w0b[e] = cw[768 + c]; w0c[e] = cw[1536 + c]; b0[e] = cb[c];
    w1a[e] = cw[256 + c]; w1b[e] = cw[768 + 256 + c]; w1c[e] = cw[1536 + 256 + c]; b1[e] = cb[256 + c];
    w2a[e] = cw[512 + c]; w2b[e] = cw[768 + 512 + c]; w2c[e] = cw[1536 + 512 + c]; b2[e] = cb[512 + c];
  }
  __syncthreads();
  {
    const f32x2 zero = {0.f, 0.f};
    for (int i = lane + 64 * hf; i < L / 2; i += 128) { zz[i] = zero; zz[3 * L / 2 + i] = zero; }
  }
  for (int s = tid; s < L; s += 256) {
    const float4 f = *(const float4*)(filt + (size_t)s * 256 + c0);
    f32x2* hA = (f32x2*)((float*)smem) + 2 * L + s;
    f32x2* hB = (f32x2*)((float*)smem + 8 * L) + 2 * L + s;
    *hA = (f32x2){f.x, f.y};
    *hB = (f32x2){f.z, f.w};
  }
#pragma unroll 1
  for (int ch = 0; ch < NI; ++ch) {
    __syncthreads();
#pragma unroll
    for (int k = 0; k < 4; ++k) {
      const int idx = tid + 256 * k;
      if (idx < 774) {
        const int reg = idx / 258, row = idx - reg * 258;
        const int t = ch * 256 - 1 + row;
        float4 v = make_float4(0.f, 0.f, 0.f, 0.f);
        if (t >= 0 && t < L) v = *(const float4*)(U + (size_t)(tok0 + t) * NIN + 2064 + reg * 256 + c0);
        *(float4*)(raw + (size_t)idx * 4) = v;
      }
    }
    __syncthreads();
#pragma unroll
    for (int k = 0; k < 2; ++k) {
      const int tl = lane + 64 * k + 128 * hf, row = tl + 1;
      const f32x2* r0 = (const f32x2*)(raw + (0 * 258 + row) * 4 + 2 * pr);
      const f32x2* r1 = (const f32x2*)(raw + (1 * 258 + row) * 4 + 2 * pr);
      const f32x2* r2 = (const f32x2*)(raw + (2 * 258 + row) * 4 + 2 * pr);
      const f32x2 x0 = b0 + w0a * r0[-2] + w0b * r0[0] + w0c * r0[2];
      const f32x2 x1 = b1 + w1a * r1[-2] + w1b * r1[0] + w1c * r1[2];
      const f32x2 vv = b2 + w2a * r2[-2] + w2b * r2[0] + w2c * r2[2];
      const int t = ch * 256 + tl;
      zz[L / 2 + t] = x1 * vv;
      x2[t] = x0;
    }
  }
  __syncthreads();
  f32x2 acc[NH][4];
  float4 hi[NH][2];
  const float4* zz4 = (const float4*)__builtin_assume_aligned(zz, 16);
  const float4* h4p = (const float4*)__builtin_assume_aligned(h2, 16);
  const int gofs = (NI >= 2) ? NH * hf : 0;
#pragma unroll
  for (int i = 0; i < NH; ++i) {
#pragma unroll
    for (int j = 0; j < 4; ++j) acc[i][j] = (f32x2){0.f, 0.f};
    const int xb = 4 * lane + 256 * (gofs + i) + L;
    hi[i][0] = zz4[xb / 2];
    hi[i][1] = zz4[xb / 2 + 1];
  }
  const bool active = (NI >= 2) || (hf == 0);
  if (active) {
    float4 lo[NH][2], hq[2];
#pragma unroll
    for (int i = 0; i < NH; ++i) {
      const int xb = 4 * lane + 256 * (gofs + i) + L - 4;
      lo[i][0] = zz4[xb / 2];
      lo[i][1] = zz4[xb / 2 + 1];
    }
    hq[0] = h4p[0];
    hq[1] = h4p[1];
#pragma unroll 2
    for (int sg = 0; sg < L / 4; ++sg) {
      const int sn = (sg + 1 < L / 4) ? sg + 1 : sg;
      float4 nlo[NH][2], nhq[2];
#pragma unroll
      for (int i = 0; i < NH; ++i) {
        const int xb = 4 * lane + 256 * (gofs + i) + L - 4 * sn - 4;
        nlo[i][0] = zz4[xb / 2];
        nlo[i][1] = zz4[xb / 2 + 1];
      }
      nhq[0] = h4p[2 * sn];
      nhq[1] = h4p[2 * sn + 1];
      const f32x2 hh[4] = {(f32x2){hq[0].x, hq[0].y}, (f32x2){hq[0].z, hq[0].w}, (f32x2){hq[1].x, hq[1].y}, (f32x2){hq[1].z, hq[1].w}};
#pragma unroll
      for (int i = 0; i < NH; ++i) {
        const float4 lo0 = lo[i][0], lo1 = lo[i][1];
        const f32x2 w[8] = {(f32x2){lo0.x, lo0.y}, (f32x2){lo0.z, lo0.w}, (f32x2){lo1.x, lo1.y}, (f32x2){lo1.z, lo1.w},
                            (f32x2){hi[i][0].x, hi[i][0].y}, (f32x2){hi[i][0].z, hi[i][0].w},
                            (f32x2){hi[i][1].x, hi[i][1].y}, (f32x2){hi[i][1].z, hi[i][1].w}};
#pragma unroll
        for (int j = 0; j < 4; ++j) {
          f32x2 a = acc[i][j];
          a = __builtin_elementwise_fma(hh[0], w[4 + j], a);
          a = __builtin_elementwise_fma(hh[1], w[3 + j], a);
          a = __builtin_elementwise_fma(hh[2], w[2 + j], a);
          a = __builtin_elementwise_fma(hh[3], w[1 + j], a);
          acc[i][j] = a;
        }
        hi[i][0] = lo0;
        hi[i][1] = lo1;
        lo[i][0] = nlo[i][0];
        lo[i][1] = nlo[i][1];
      }
      hq[0] = nhq[0];
      hq[1] = nhq[1];
    }
  }
  f32x2 hb;
  hb[0] = pin(p, I_HBIAS)[l * 256 + ca];
  hb[1] = pin(p, I_HBIAS)[l * 256 + ca + 1];
  bf16_t* obuf = (bf16_t*)raw;
  if (active) {
#pragma unroll
    for (int i = 0; i < NH; ++i)
#pragma unroll
      for (int j = 0; j < 4; ++j) {
        const int t = 4 * lane + 256 * (gofs + i) + j;
        const f32x2 y = acc[i][j] + hb * zz[t + L / 2];
        const f32x2 o = x2[t] * y;
        *(unsigned*)(obuf + t * 4 + 2 * pr) = pack2(o[0], o[1]);
      }
  }
  __syncthreads();
  for (int t = tid; t < L; t += 256)
    *(uint2*)(YM + (size_t)(tok0 + t) * DM + 768 + c0) = *(const uint2*)(obuf + t * 4);
}

constexpr int FLAG_WORD0 = 3584;
DI void mlstm_dir_item(const Params& p, int l, bool lat, int bidx, int tok0, int L, int head, int dir, int* flag, char* smem) {
  const int tid = otid(), lane = tid & 63, g = lane >> 4, r16 = lane & 15;
  const int wid = __builtin_amdgcn_readfirstlane(tid >> 6);
  bf16_t* Qs = (bf16_t*)smem;
  bf16_t* Ks = Qs + 64 * 72;
  bf16_t* Vt = Ks + 64 * 72;
  bf16_t* Ct = Vt + 64 * 72;
  bf16_t* Sp = Ct + 64 * 72;
  bf16_t* KwT = Sp + 64 * 72;
  float* vec = (float*)(smem + 6 * 9216);
  float* v_d1 = vec + 320;
  float* S_bc = (float*)(smem + 6 * 9216 + 4096);
  float* S_amb = S_bc + 1024;
  float* S_mt = S_amb + 1024;
  float* S_wi = S_mt + 1024;
  float* S_wk = S_wi + 1024;
  float* S_btot = S_wk + 1024;
  float* S_mx = S_btot + 16;
  float* S_dec = S_mx + 16;
  float* S_mnew = S_dec + 16;
  float* v_d2 = vec + 384;
  float* v_np = vec + 640;
  float* v_n = vec + 896;
  float* v_sc = vec + 960;
  const float* U = (const float*)(pws(p, OFF_U));
  float* HD = (float*)(pws(p, dir == 0 ? OFF_HF : OFF_HB));
  const int nc = L / 64;
  const float gbi = pin(p, I_BG)[l * 16 + dir * 4 + head];
  const float gbf = pin(p, I_BG)[l * 16 + 8 + dir * 4 + head];
  const size_t sidx = ((size_t)((bidx * 2 + l) * 2 + dir)) * 4 + head;

  f32x4 cacc[4];
  __syncthreads();
  if (lat) {
    const float* sc = pin(p, I_SC) + sidx * 4096;
#pragma unroll
    for (int et = 0; et < 4; ++et)
#pragma unroll
      for (int j = 0; j < 4; ++j) cacc[et][j] = sc[(wid * 16 + g * 4 + j) * 64 + et * 16 + r16];
    if (tid < 64) v_n[tid] = pin(p, I_SN)[sidx * 64 + tid];
    if (tid == 0) v_sc[0] = pin(p, I_SM)[sidx];
  } else {
#pragma unroll
    for (int et = 0; et < 4; ++et) cacc[et] = (f32x4){0.f, 0.f, 0.f, 0.f};
    if (tid < 64) v_n[tid] = 0.f;
    if (tid == 0) v_sc[0] = 0.f;
  }
#pragma unroll
  for (int et = 0; et < 4; ++et)
    *(uint2*)(Ct + (et * 16 + r16) * 72 + wid * 16 + g * 4) =
        make_uint2(pack2(cacc[et][0], cacc[et][1]), pack2(cacc[et][2], cacc[et][3]));

  for (int c = wid; c < nc; c += 4) {
    const int pos = c * 64 + lane;
    const int tok = tok0 + (dir == 0 ? pos : L - 1 - pos);
    const float igv = U[(size_t)tok * NIN + 1024 + dir * 4 + head] + gbi;
    const float fgv = U[(size_t)tok * NIN + 1032 + dir * 4 + head] + gbf;
    const float lf = fminf(fgv, 0.f) - __logf(1.f + __expf(-fabsf(fgv)));
    float bc = lf;
#pragma unroll
    for (int o = 1; o < 64; o <<= 1) {
      float up = __shfl_up(bc, o);
      if (lane >= o) bc += up;
    }
    const float amb = igv - bc;
    float pm = amb;
#pragma unroll
    for (int o = 1; o < 64; o <<= 1) {
      float up = __shfl_up(pm, o);
      if (lane >= o) pm = fmaxf(pm, up);
    }
    const float btot = __shfl(bc, 63);
    const float wlog = btot - bc + igv;
    float mx = wlog;
    mx = fmaxf(mx, shx<32>(mx)); mx = fmaxf(mx, shx<16>(mx)); mx = fmaxf(mx, shx<8>(mx));
    mx = fmaxf(mx, shx<4>(mx)); mx = fmaxf(mx, shx<2>(mx)); mx = fmaxf(mx, shx<1>(mx));
    S_bc[c * 64 + lane] = bc;
    S_amb[c * 64 + lane] = amb;
    S_mt[c * 64 + lane] = bc + pm;
    S_wk[c * 64 + lane] = wlog;
    if (lane == 0) { S_btot[c] = btot; S_mx[c] = mx; }
  }
  __syncthreads();
  if (wid == 0) {
    float m_old = v_sc[0];
    for (int c = 0; c < nc; ++c) {
      const float bc = S_bc[c * 64 + lane];
      const float inter = bc + m_old;
      const float mt = fmaxf(S_mt[c * 64 + lane], inter);
      const float btot = S_btot[c];
      const float m_new = fmaxf(btot + m_old, S_mx[c]);
      S_mt[c * 64 + lane] = mt;
      S_wi[c * 64 + lane] = __expf(inter - mt);
      S_wk[c * 64 + lane] = __expf(S_wk[c * 64 + lane] - m_new);
      if (lane == 0) { S_dec[c] = __expf(btot + m_old - m_new); S_mnew[c] = m_new; }
      m_old = m_new;
    }
  }
  __syncthreads();
  float4 pq[4], pk4[4], pv4[4];
#define MLSTM_FETCH(ci_)                                                                                             \
  do {                                                                                                               \
    _Pragma("unroll") for (int j = 0; j < 4; ++j) {                                                                  \
      const int cidx = tid + 256 * j, row = cidx >> 4, d4 = (cidx & 15) * 4;                                         \
      const int pos = (ci_) * 64 + row;                                                                              \
      const int tok = tok0 + (dir == 0 ? pos : L - 1 - pos);                                                         \
      const float* ur = U + (size_t)tok * NIN + head * 64 + d4;                                                      \
      pq[j] = *(const float4*)(ur);                                                                                  \
      pk4[j] = *(const float4*)(ur + 256);                                                                           \
      pv4[j] = *(const float4*)(ur + 512);                                                                           \
    }                                                                                                                \
  } while (0)
  MLSTM_FETCH(0);
  for (int ci = 0; ci < nc; ++ci) {
#pragma unroll
    for (int j = 0; j < 4; ++j) {
      const int cidx = tid + 256 * j, row = cidx >> 4, d4 = (cidx & 15) * 4;
      const float4 qv = pq[j], kv = pk4[j], vv = pv4[j];
      *(uint2*)(Qs + row * 72 + d4) = make_uint2(pack2(qv.x, qv.y), pack2(qv.z, qv.w));
      *(uint2*)(Ks + row * 72 + d4) =
          make_uint2(pack2(kv.x * 0.125f, kv.y * 0.125f), pack2(kv.z * 0.125f, kv.w * 0.125f));
      Vt[(d4 + 0) * 72 + row] = f2bf(vv.x);
      Vt[(d4 + 1) * 72 + row] = f2bf(vv.y);
      Vt[(d4 + 2) * 72 + row] = f2bf(vv.z);
      Vt[(d4 + 3) * 72 + row] = f2bf(vv.w);
    }
    if (ci + 1 < nc) MLSTM_FETCH(ci + 1);
    const float* v_bc = S_bc + ci * 64;
    const float* v_amb = S_amb + ci * 64;
    const float* v_mt = S_mt + ci * 64;
    const float* v_wi = S_wi + ci * 64;
    const float* v_wk = S_wk + ci * 64;
    __syncthreads();
    f32x4 sp[4];
    unsigned n2k[4][2];
    {
      bf16x8 qa[2];
#pragma unroll
      for (int ds = 0; ds < 2; ++ds) qa[ds] = *(const bf16x8*)(Qs + (wid * 16 + r16) * 72 + ds * 32 + g * 8);
#pragma unroll
      for (int st = 0; st < 4; ++st) {
        bf16x8 kb0 = *(const bf16x8*)(Ks + (st * 16 + r16) * 72 + g * 8);
        bf16x8 kb1 = *(const bf16x8*)(Ks + (st * 16 + r16) * 72 + 32 + g * 8);
        bf16x8 cb0 = *(const bf16x8*)(Ct + (st * 16 + r16) * 72 + g * 8);
        bf16x8 cb1 = *(const bf16x8*)(Ct + (st * 16 + r16) * 72 + 32 + g * 8);
        f32x4 z = (f32x4){0.f, 0.f, 0.f, 0.f};
        z = MFMA16(qa[0], kb0, z);
        sp[st] = MFMA16(qa[1], kb1, z);
        f32x4 y = (f32x4){0.f, 0.f, 0.f, 0.f};
        y = MFMA16(qa[0], cb0, y);
        y = MFMA16(qa[1], cb1, y);
        n2k[st][0] = pack2(y[0], y[1]);
        n2k[st][1] = pack2(y[2], y[3]);
      }
    }
    {
      float s = 0.f;
#pragma unroll
      for (int d = 0; d < 16; ++d) s += bf2f(Qs[lane * 72 + wid * 16 + d]) * v_n[wid * 16 + d];
      v_d2[wid * 64 + lane] = s;
    }
#pragma unroll
    for (int j = 0; j < 4; ++j) {
      const int t = wid * 16 + g * 4 + j;
      const float bt = v_bc[t] - v_mt[t];
      float rs = 0.f;
#pragma unroll
      for (int st = 0; st < 4; ++st) {
        const int s = st * 16 + r16;
        float wgt = (s <= t) ? __expf(bt + v_amb[s]) : 0.f;
        float val = sp[st][j] * wgt;
        sp[st][j] = val;
        rs += val;
      }
      rs += shx<1>(rs); rs += shx<2>(rs); rs += shx<4>(rs); rs += shx<8>(rs);
      if (r16 == 0) v_d1[t] = rs;
    }
#pragma unroll
    for (int st = 0; st < 4; ++st)
#pragma unroll
      for (int j = 0; j < 4; ++j) Sp[(wid * 16 + g * 4 + j) * 72 + st * 16 + r16] = f2bf(sp[st][j]);
    {
      const int s = tid & 63, dq = (tid >> 6) * 16;
      const float wk = v_wk[s];
#pragma unroll
      for (int d8 = 0; d8 < 2; ++d8) {
        bf16x8 kk = *(const bf16x8*)(Ks + s * 72 + dq + d8 * 8);
#pragma unroll
        for (int i = 0; i < 8; ++i) KwT[(dq + d8 * 8 + i) * 72 + s] = f2bf(bf2f((bf16_t)kk[i]) * wk);
      }
    }
    const float decay = S_dec[ci];
    {
      float s = 0.f;
#pragma unroll
      for (int q = 0; q < 16; ++q) s += v_wk[wid * 16 + q] * bf2f(Ks[(wid * 16 + q) * 72 + lane]);
      v_np[wid * 64 + lane] = s;
    }
    __syncthreads();
    if (wid == 0) v_n[lane] = decay * v_n[lane] + (v_np[lane] + v_np[64 + lane]) + (v_np[128 + lane] + v_np[192 + lane]);
    {
      bf16x8 sa[2], ka[2];
#pragma unroll
      for (int ks = 0; ks < 2; ++ks) {
        sa[ks] = *(const bf16x8*)(Sp + (wid * 16 + r16) * 72 + ks * 32 + g * 8);
        ka[ks] = *(const bf16x8*)(KwT + (wid * 16 + r16) * 72 + ks * 32 + g * 8);
      }
      float wi[4], dn[4];
      int tokr[4];
#pragma unroll
      for (int j = 0; j < 4; ++j) {
        const int t = wid * 16 + g * 4 + j;
        wi[j] = v_wi[t];
        float den = v_d1[t] + wi[j] * (v_d2[t] + v_d2[64 + t] + v_d2[128 + t] + v_d2[192 + t]);
        dn[j] = 1.f / fmaxf(fabsf(den), __expf(-v_mt[t]));
        const int pos = ci * 64 + t;
        tokr[j] = tok0 + (dir == 0 ? pos : L - 1 - pos);
      }
#pragma unroll
      for (int et = 0; et < 4; ++et) {
        bf16x8 vb0 = *(const bf16x8*)(Vt + (et * 16 + r16) * 72 + g * 8);
        bf16x8 vb1 = *(const bf16x8*)(Vt + (et * 16 + r16) * 72 + 32 + g * 8);
        f32x4 z = (f32x4){0.f, 0.f, 0.f, 0.f};
        z = MFMA16(sa[0], vb0, z);
        z = MFMA16(sa[1], vb1, z);
#pragma unroll
        for (int j = 0; j < 4; ++j) {
          float n2v = __uint_as_float((j & 1) ? (n2k[et][j >> 1] & 0xffff0000u) : (n2k[et][j >> 1] << 16));
          float hv = (z[j] + wi[j] * n2v) * dn[j];
          HD[(size_t)tokr[j] * 256 + head * 64 + et * 16 + r16] = hv;
        }
        f32x4 cc = cacc[et] * decay;
        cc = MFMA16(ka[0], vb0, cc);
        cacc[et] = MFMA16(ka[1], vb1, cc);
      }
    }
#pragma unroll
    for (int et = 0; et < 4; ++et)
      *(uint2*)(Ct + (et * 16 + r16) * 72 + wid * 16 + g * 4) =
          make_uint2(pack2(cacc[et][0], cacc[et][1]), pack2(cacc[et][2], cacc[et][3]));
    __syncthreads();
  }
#undef MLSTM_FETCH
  if (!lat) {
    float* oc = pout(p) + O_NC + sidx * 4096;
#pragma unroll
    for (int et = 0; et < 4; ++et)
#pragma unroll
      for (int j = 0; j < 4; ++j) oc[(wid * 16 + g * 4 + j) * 64 + et * 16 + r16] = cacc[et][j];
    if (wid == 0) pout(p)[O_NN + sidx * 64 + lane] = v_n[lane];
    if (tid == 0) pout(p)[O_NM + sidx] = S_mnew[nc - 1];
  }
  asm volatile("s_waitcnt vmcnt(0)" ::: "memory");
  __syncthreads();
  if (tid == 0) {
    __builtin_amdgcn_fence(__ATOMIC_RELEASE, "agent");
    asm volatile("s_waitcnt vmcnt(0)" ::: "memory");
    __hip_atomic_fetch_add(flag, 1, __ATOMIC_RELAXED, __HIP_MEMORY_SCOPE_AGENT);
  }
}

DI void mlstm_combine_item(const Params& p, int l, int tok0, int head, int* flag, bf16_t* YM) {
  const int tid = otid();
  if (tid == 0) {
    unsigned spins = 0;
    while (__hip_atomic_load(flag, __ATOMIC_RELAXED, __HIP_MEMORY_SCOPE_AGENT) < 2) {
      __builtin_amdgcn_s_sleep(2);
      if (++spins > (1u << 22)) break;
    }
    __builtin_amdgcn_fence(__ATOMIC_ACQUIRE, "agent");
    asm volatile("s_waitcnt vmcnt(0)" ::: "memory");
  }
  __syncthreads();
  const float* U = (const float*)(pws(p, OFF_U));
  const float* HF = (const float*)(pws(p, OFF_HF));
  const float* HB = (const float*)(pws(p, OFF_HB));
  const float* gm = pin(p, I_GML) + l * 256 + head * 64;
  const int i16 = tid & 15;
#pragma unroll 4
  for (int tt = tid >> 4; tt < 256; tt += 16) {
    const size_t tok = tok0 + tt;
    float4 a = *(const float4*)(HF + tok * 256 + head * 64 + i16 * 4);
    float4 b = *(const float4*)(HB + tok * 256 + head * 64 + i16 * 4);
    float h0 = a.x + b.x, h1 = a.y + b.y, h2 = a.z + b.z, h3 = a.w + b.w;
    float ss = h0 * h0 + h1 * h1 + h2 * h2 + h3 * h3;
    ss += shx<1>(ss); ss += shx<2>(ss); ss += shx<4>(ss); ss += shx<8>(ss);
    const float r = rsqrtf(ss * (1.0f / 64.0f) + EPS);
    float4 ov = *(const float4*)(U + tok * NIN + 768 + head * 64 + i16 * 4);
    float4 gg = *(const float4*)(gm + i16 * 4);
    float y0 = h0 * r * gg.x * sigmoidf_(ov.x);
    float y1 = h1 * r * gg.y * sigmoidf_(ov.y);
    float y2 = h2 * r * gg.z * sigmoidf_(ov.z);
    float y3 = h3 * r * gg.w * sigmoidf_(ov.w);
    *(uint2*)(YM + tok * DM + head * 64 + i16 * 4) = make_uint2(pack2(y0, y1), pack2(y2, y3));
  }
}

DI void phase_mixer(const Params& p, int lc, int kindmask, char* smem) {
  __shared__ int s_item;
  int* ctr = (int*)(pws(p, OFF_BAR)) + lc;
  const int l = lc & 1;
  bf16_t* YM = (bf16_t*)(pws(p, OFF_H));
  const bf16_t* QB = (const bf16_t*)(pws(p, OFF_QB));
  const bf16_t* QC = (const bf16_t*)(pws(p, OFF_QC));
  const bf16_t* KB = (const bf16_t*)(pws(p, OFF_KB));
  const bf16_t* VB = (const bf16_t*)(pws(p, OFF_VB));
  const bf16_t* KC = (const bf16_t*)(pws(p, OFF_KC));
  const bf16_t* VC = (const bf16_t*)(pws(p, OFF_VC));
  const int total = 32 + 128 + 256 + 128 + 128 + 128 + 128 + 1024 + 128;
  int* flags = (int*)(pws(p, OFF_BAR)) + FLAG_WORD0 + l * 80;
  while (true) {
    __syncthreads();
    if (otid() == 0) s_item = atomicAdd(ctr, 1);
    __syncthreads();
    int it = __builtin_amdgcn_readfirstlane(s_item);
    if (it >= total) break;
    int kind;
    bool lat = false, gl = false;
    int a0 = 0, a1 = 0, a2 = 0;
    if (it < 32) { kind = 0; lat = true; a0 = it >> 3; a1 = (it >> 1) & 3; a2 = it & 1; }
    else if ((it -= 32) < 128) { kind = 1; lat = true; gl = true; a0 = it >> 5; a1 = (it >> 3) & 3; a2 = it & 7; }
    else if ((it -= 128) < 256) { kind = 2; a0 = it >> 6; a1 = it & 63; }
    else if ((it -= 256) < 128) { kind = 1; lat = true; gl = false; a0 = it >> 5; a1 = (it >> 3) & 3; a2 = it & 7; }
    else if ((it -= 128) < 128) { kind = 0; lat = false; a0 = it >> 3; a1 = (it >> 1) & 3; a2 = it & 1; }
    else if ((it -= 128) < 128) { kind = 1; lat = false; gl = true; a0 = it >> 3; a1 = (it >> 1) & 3; a2 = it & 1; }
    else if ((it -= 128) < 128) { kind = 1; lat = false; gl = false; a0 = it >> 3; a1 = (it >> 1) & 3; a2 = it & 1; }
    else if ((it -= 128) < 1024) { kind = 3; a0 = it >> 6; a1 = it & 63; }
    else { it -= 1024; kind = 4; }
    if (kind == 4) {
      int tok0c, headc, fidx;
      if (it < 64) { const int sq = it >> 4; headc = (it >> 2) & 3; tok0c = NCTX + sq * 1024 + (it & 3) * 256; fidx = sq * 4 + headc; }
      else { const int sq = (it - 64) >> 2; headc = (it - 64) & 3; tok0c = sq * 256; fidx = 16 + sq * 4 + headc; }
      mlstm_combine_item(p, l, tok0c, headc, flags + fidx, YM);
      continue;
    }
    if (!((kindmask >> kind) & 1)) continue;
    if (kind == 0) {
#ifndef SKIP_MLSTM
      mlstm_dir_item(p, l, lat, a0, lat ? NCTX + a0 * 1024 : a0 * 256, lat ? 1024 : 256, a1, a2,
                     flags + (lat ? a0 * 4 + a1 : 16 + a0 * 4 + a1), smem);
#endif
    } else if (kind == 1) {
      const int head = a1, qb = a2;
      const int tok0 = lat ? NCTX + a0 * 1024 : a0 * 256;
      const size_t kr = (size_t)(lat ? NCTX + a0 * 1280 : tok0) * 128 + (head >> 1) * 64;
      int n1, start2 = 0, n2 = 0;
      if (lat && gl) n1 = 20;
      else if (lat) {
        const int lo = 2 * qb - 2 < 0 ? 0 : 2 * qb - 2, hi = 2 * qb + 3 > 15 ? 15 : 2 * qb + 3;
        n1 = 4; start2 = 4 + lo; n2 = hi - lo + 1;
      } else n1 = 4;
      const float sink = gl ? 0.f : pin(p, I_SINK)[l * 4 + head];
      attn_item((gl ? QB : QC) + (size_t)tok0 * 256 + head * 64, (gl ? KB : KC) + kr, (gl ? VB : VC) + kr, qb * 128, n1,
                start2, n2, lat && !gl, !gl, sink, YM + (size_t)tok0 * DM + (gl ? 256 : 512) + head * 64, smem);
    } else if (kind == 2) {
#ifndef SKIP_HYENA
      hyena_item<4>(p, l, NCTX + a0 * 1024, a1, YM, smem);
#endif
    } else {
#ifndef SKIP_HYENA
      hyena_item<1>(p, l, a0 * 256, a1, YM, smem);
#endif
    }
  }
}

__global__ void __launch_bounds__(256, 2) trunk_megakernel(Params p) {
  extern __shared__ __attribute__((aligned(16))) char smem[];
  cg::grid_group grid = cg::this_grid();
  __shared__ uint4 xb_words;
  if (threadIdx.x == 0) xb_words = make_uint4(0u, 0u, 0u, 0u);
  __syncthreads();
  if (p.out == nullptr) grid.sync();
  XcdBarrier xb = xcd_barrier_post((unsigned*)(pws(p, OFF_BAR)), (volatile LAS unsigned*)&xb_words);

#pragma unroll 1
  for (int ph = 0; ph < 24; ++ph) {
    const bf16_t* WT = (const bf16_t*)(pws(p, OFF_WT));
    const bf16_t* H = (const bf16_t*)(pws(p, OFF_H));
    float* X = (float*)(pws(p, OFF_X));
    float* U = (float*)(pws(p, OFF_U));
    bf16_t* ACT = (bf16_t*)(pws(p, OFF_U));
    const float* MOD = (const float*)(pws(p, OFF_MOD));
    if (ph == 0) {
#pragma unroll 1
      for (int rep = 0; rep < REP_PRO; ++rep) phase_prologue(p, smem);
    } else if (ph == 23) {
      phase_final_norm(p);
    } else {
      const int l = (ph - 1) / 11, s = (ph - 1) % 11;
      const float* modl = MOD + (size_t)l * 5 * NMOD;
      if (s == 0 || s == 3 || s == 8) {
        const float* g = (s == 0 ? pin(p, I_GFF1) : s == 3 ? pin(p, I_GMIX) : pin(p, I_GFF2)) + l * DM;
        const int ps = (s == 0) ? 0 : (s == 3) ? 3 : 6;
#pragma unroll 1
        for (int rep = 0; rep < REP_SMALL; ++rep)
          phase_norm(p, l, l == 0 && s == 0, g, ps, ps + 1);
        if (s == 0 && l == 1) {
#pragma unroll 1
          for (int rep = 0; rep < REP_PRO; ++rep) convert_layer(p, 1, smem);
        }
      } else if (s == 1 || s == 9) {
        EpiArgs ea{ACT, nullptr, nullptr, nullptr, 0.f};
#ifndef REP_GEMM
#define REP_GEMM 1
#endif
#pragma unroll 1
        for (int rep = 0; rep < REP_GEMM; ++rep)
        {
          gemm_k64<EPI_GU>(H, DM, WT + (s == 1 ? WT_GU1 : WT_GU2), DM, NTOK, NGU, DM, ea, smem);
        }
      } else if (s == 2 || s == 7 || s == 10) {
        const bool first = (l == 0 && s == 2);
        EpiArgs ea{X, first ? pin(p, I_XP) : X, first ? pin(p, I_XS) : X + (size_t)NCTX * DM,
                   modl + (s == 2 ? 2 : s == 7 ? 5 : 8) * 1024, s == 7 ? 1.0f : 0.5f};
        const bf16_t* A = (s == 7) ? H : ACT;
        const int K = (s == 7) ? DM : DFF;
        const bf16_t* B = WT + (s == 2 ? WT_D1 : s == 7 ? WT_OUT : WT_D2);
        gemm_k64<EPI_RES>(A, K, B, K, NTOK, DM, K, ea, smem);
#if REP_RES > 1
        {
          xcd_barrier(xb);
          EpiArgs eb{X, X, X + (size_t)NCTX * DM, ea.modp, 0.0f};
          gemm_k64<EPI_RES>(A, K, B, K, NTOK, DM, K, eb, smem);
        }
#endif
      } else if (s == 4) {
        EpiArgs ea{U, nullptr, nullptr, nullptr, 0.f};
#pragma unroll 1
        for (int rep = 0; rep < REP_GEMM; ++rep)
          gemm_k64<EPI_U>(H, DM, WT + WT_IN, DM, NTOK, NIN, DM, ea, smem);
      } else if (s == 5) {
#ifndef REP_SMALL
#define REP_SMALL 1
#endif
#pragma unroll 1
        for (int rep = 0; rep < REP_SMALL; ++rep)
          phase_prep(p, l);
      } else {
#ifndef REP_MIXER
#define REP_MIXER 1
#endif
#pragma unroll 1
        for (int rep = 0; rep < REP_MIXER; ++rep)
          phase_mixer(p, l + 2 * rep, rep == 0 ? 15 : REP_MASK, smem);
      }
    }
    if (ph < 23) {
      xcd_barrier(xb);
#if REP_BAR > 1
      xcd_barrier(xb);
#endif
    }
  }
}

extern "C" void kernel_launch(void* const* d_in, const int* in_sizes, int n_in, void* d_out, int out_size, void* d_ws,
                              size_t ws_size, hipStream_t stream) {
  static int grid_blocks = 0;
  if (!grid_blocks) {
    int dev = 0, cus = 0, per_cu = 0;
    hipGetDevice(&dev);
    hipDeviceGetAttribute(&cus, hipDeviceAttributeMultiprocessorCount, dev);
    hipFuncSetAttribute((const void*)trunk_megakernel, hipFuncAttributeMaxDynamicSharedMemorySize, LDS_BYTES);
    hipOccupancyMaxActiveBlocksPerMultiprocessor(&per_cu, trunk_megakernel, 256, LDS_BYTES);
    if (per_cu > 2) per_cu = 2;
    if (per_cu < 1) per_cu = 1;
    grid_blocks = cus * per_cu;
  }
  Params p{};
  for (int i = 0; i < 40; ++i) p.in[i] = (const float*)d_in[i];
  p.out = (float*)d_out;
  p.ws = (char*)d_ws;
  hipMemsetAsync((char*)d_ws + OFF_BAR, 0, 16384, stream);
  void* args[] = {&p};
  hipError_t e = hipLaunchCooperativeKernel((void*)trunk_megakernel, dim3(grid_blocks), dim3(256), args, LDS_BYTES, stream);
  if (e != hipSuccess) fprintf(stderr, "cooperative launch failed: %s (grid %d)\n", hipGetErrorString(e), grid_blocks);
}

#ifdef PROBE_PHASES
__global__ void __launch_bounds__(256, 2) k_mod(Params p) { extern __shared__ __attribute__((aligned(16))) char smem[]; mod_item(p, blockIdx.x, smem); }
__global__ void __launch_bounds__(256, 2) k_filt(Params p) { extern __shared__ __attribute__((aligned(16))) char smem[]; filt_item(p, blockIdx.x, smem); }
__global__ void __launch_bounds__(256, 2) k_conv(Params p) { extern __shared__ __attribute__((aligned(16))) char smem[]; convert_layer(p, 0, smem); }
__global__ void __launch_bounds__(256, 2) k_pro(Params p) { extern __shared__ __attribute__((aligned(16))) char smem[]; phase_prologue(p, smem); }
__global__ void __launch_bounds__(256, 2) k_norm(Params p) { phase_norm(p, 0, true, p.in[I_GFF1], 0, 1); }
__global__ void __launch_bounds__(256, 2) k_gemm_gu(Params p) { extern __shared__ __attribute__((aligned(16))) char smem[]; EpiArgs ea{p.ws, nullptr, nullptr, nullptr, 0.f}; gemm_phase<EPI_GU>((bf16_t*)p.ws, DM, (bf16_t*)p.ws, DM, NTOK, NGU, DM, ea, smem); }
__global__ void __launch_bounds__(256, 2) k_gemm_res(Params p) { extern __shared__ __attribute__((aligned(16))) char smem[]; EpiArgs ea{p.ws, p.in[0], p.in[1], p.in[2], 0.5f}; gemm_phase<EPI_RES>((bf16_t*)p.ws, DM, (bf16_t*)p.ws, DM, NTOK, DM, DM, ea, smem); }
__global__ void __launch_bounds__(256, 2) k_gemm_u(Params p) { extern __shared__ __attribute__((aligned(16))) char smem[]; EpiArgs ea{p.ws, nullptr, nullptr, nullptr, 0.f}; gemm_phase<EPI_U>((bf16_t*)p.ws, DM, (bf16_t*)p.ws, DM, NTOK, NIN, DM, ea, smem); }
__global__ void __launch_bounds__(256, 2) k_prep(Params p) { phase_prep(p, 0); }
__global__ void __launch_bounds__(256, 2) k_attn(Params p, int a, int b, int c, int d, bool w, bool hs, float sk) { extern __shared__ __attribute__((aligned(16))) char smem[]; attn_item((bf16_t*)p.ws, (bf16_t*)p.ws, (bf16_t*)p.ws, a, b, c, d, w, hs, sk, (bf16_t*)p.ws, smem); }
__global__ void __launch_bounds__(256, 2) k_hy4(Params p) { extern __shared__ __attribute__((aligned(16))) char smem[]; hyena_item<4>(p, 0, 0, blockIdx.x, (bf16_t*)p.ws, smem); }
__global__ void __launch_bounds__(256, 2) k_hy1(Params p) { extern __shared__ __attribute__((aligned(16))) char smem[]; hyena_item<1>(p, 0, 0, blockIdx.x, (bf16_t*)p.ws, smem); }
__global__ void __launch_bounds__(256, 2) k_mixer(Params p) { extern __shared__ __attribute__((aligned(16))) char smem[]; phase_mixer(p, 0, 15, smem); }
#endif
```

```cpp
#include <hip/hip_runtime.h>
#include <hip/hip_cooperative_groups.h>
#include <cstdio>
namespace cg = cooperative_groups;

#define DI __device__ __forceinline__
typedef unsigned short bf16_t;
using bf16x8 = __attribute__((ext_vector_type(8))) short;
using bf16x4 = __attribute__((ext_vector_type(4))) short;
using f32x4 = __attribute__((ext_vector_type(4))) float;

constexpr int NTOK = 8192, NCTX = 4096, DM = 1024, DFF = 2816, NIN = 2832, NGU = 5632;
constexpr int NMOD = 9216;
constexpr float EPS = 1e-6f;

enum { I_XP = 0, I_XS, I_SC, I_SN, I_SM, I_CGK, I_CGV, I_CSK, I_CSV, I_C, I_CCTX, I_WADA, I_BADA, I_GFF1,
       I_W1G, I_W1U, I_W1D, I_GMIX, I_WIN, I_BG, I_GML, I_GQN, I_GKN, I_SINK, I_CW, I_CB, I_FW1, I_FB1,
       I_FW2, I_FB2, I_FW3, I_FB3, I_FFR, I_HBIAS, I_WOUT, I_GFF2, I_W2G, I_W2U, I_W2D, I_GFIN };

constexpr size_t O_Y = 0, O_NC = 8388608, O_NN = 9437184, O_NM = 9453568, O_GK = 9453824, O_GV = 10502400,
                 O_SK = 11550976, O_SV = 12599552;

constexpr size_t MiB = 1u << 20;
constexpr size_t OFF_WT = 0, OFF_X = 44 * MiB, OFF_H = 76 * MiB, OFF_U = 92 * MiB, OFF_QB = 181 * MiB,
                 OFF_QC = 185 * MiB, OFF_KB = 189 * MiB, OFF_VB = 192 * MiB, OFF_KC = 195 * MiB, OFF_VC = 198 * MiB,
                 OFF_HF = 201 * MiB, OFF_HB = 209 * MiB, OFF_MOD = 217 * MiB, OFF_FILT = 218 * MiB,
                 OFF_ROPE = 221 * MiB, OFF_CTR = 222 * MiB, OFF_BAR = 223 * MiB;
constexpr size_t WT_GU1 = 0, WT_D1 = 5767168, WT_IN = 8650752, WT_OUT = 11550720, WT_GU2 = 12599296, WT_D2 = 18366464;

#ifndef REP_GEMM
#define REP_GEMM 1
#endif
#ifndef REP_MIXER
#define REP_MIXER 1
#endif
#ifndef REP_SMALL
#define REP_SMALL 1
#endif
#ifndef REP_PRO
#define REP_PRO 1
#endif
#define REP_RES 1
#define REP_MASK 15
#define REP_BAR 1
constexpr int LDS_BYTES = 79 * 1024;

struct Params {
  const float* in[40];
  float* out;
  char* ws;
};

DI const float* pin(const Params& p, int i) {
  asm volatile("" : "+s"(i));
  return p.in[i];
}
DI char* pws(const Params& p, size_t off) {
  asm volatile("" : "+s"(off));
  return p.ws + off;
}
DI float* pout(const Params& p) {
  int z = 0;
  asm volatile("" : "+s"(z));
  return p.out + z;
}
DI int otid() {
  int t = threadIdx.x;
  asm volatile("" : "+v"(t));
  return t;
}
DI int obid() {
  int b = blockIdx.x;
  asm volatile("" : "+s"(b));
  return b;
}
DI bf16_t f2bf(float x) {
  unsigned u = __float_as_uint(x);
  u += 0x7fffu + ((u >> 16) & 1u);
  return (bf16_t)(u >> 16);
}
DI float bf2f(bf16_t h) { return __uint_as_float(((unsigned)h) << 16); }
DI unsigned pack2(float a, float b) { return (unsigned)f2bf(a) | ((unsigned)f2bf(b) << 16); }
template <int K>
DI float shx(float v) {
  if constexpr (K < 32) return __int_as_float(__builtin_amdgcn_ds_swizzle(__float_as_int(v), (K << 10) | 0x1f));
  else return __shfl_xor(v, K);
}
DI float wave_sum(float v) {
  v += shx<32>(v); v += shx<16>(v); v += shx<8>(v); v += shx<4>(v); v += shx<2>(v); v += shx<1>(v);
  return v;
}
DI float sigmoidf_(float x) { return 1.f / (1.f + __expf(-x)); }
DI int mod_index(int row) { return row < NCTX ? 0 : 1 + ((row - NCTX) >> 10); }
#define MFMA16(a, b, c) __builtin_amdgcn_mfma_f32_16x16x32_bf16((a), (b), (c), 0, 0, 0)


#define XB_TMO      128
#define XB_XCNT(j)  (256  + 64 * (j))
#define XB_XSUB(j)  (1280 + 64 * (j))
#define XB_XGEN(j)  (2304 + 64 * (j))
#define XB_TOP      3328
#define XB_TOPGEN   3392
#define XCD_BAR_WORDS 3456
#define XB_SPIN_CAP (1u << 20)
#define LAS __attribute__((address_space(3)))
DI unsigned xb_ld(unsigned* p) { return __hip_atomic_load(p, __ATOMIC_RELAXED, __HIP_MEMORY_SCOPE_AGENT); }
DI unsigned xb_add(unsigned* p, unsigned v) { return __hip_atomic_fetch_add(p, v, __ATOMIC_RELAXED, __HIP_MEMORY_SCOPE_AGENT); }
DI unsigned xb_xcc_id() { return (unsigned)__builtin_amdgcn_s_getreg((3 << 11) | 20) & 0xFu; }
#define XB_SPIN(cond, bar) do { unsigned _sp = 0; while (cond) { __builtin_amdgcn_s_sleep(1); \
    if ((++_sp & 255u) == 0u) { if (xb_ld(&(bar)[XB_TMO])) break; if (_sp > XB_SPIN_CAP) { atomicAdd(&(bar)[XB_TMO], 1u); break; } } } } while (0)
struct XcdBarrier {
  unsigned* bar; unsigned x;
  volatile LAS unsigned* st;
};
DI XcdBarrier xcd_barrier_post(unsigned* bar, volatile LAS unsigned* st) {
  XcdBarrier b; b.bar = bar; b.x = xb_xcc_id(); b.st = st;
  if (threadIdx.x == 0) (void)xb_add(&bar[XB_XCNT(b.x)], 1u);
  return b;
}
DI void xcd_barrier_complete(unsigned* bar, unsigned x, unsigned& nloc, unsigned& nx) {
  const unsigned G = gridDim.x * gridDim.y * gridDim.z;
  unsigned sum, cnt, mine, sp = 0u;
  for (;;) {
    sum = 0u; cnt = 0u; mine = 0u;
#pragma unroll 1
    for (unsigned j = 0; j < 16; ++j) { const unsigned c = xb_ld(&bar[XB_XCNT(j)]); sum += c; cnt += (c > 0u) ? 1u : 0u; mine = (j == x) ? c : mine; }
    if (sum == G) break;
    __builtin_amdgcn_s_sleep(1);
    if ((++sp & 255u) == 0u) { if (xb_ld(&bar[XB_TMO])) break; if (sp > XB_SPIN_CAP) { atomicAdd(&bar[XB_TMO], 1u); break; } }
  }
  nloc = mine > 0u ? mine : 1u; nx = cnt > 0u ? cnt : 1u;
}
DI void xcd_barrier(const XcdBarrier& b) {
  asm volatile("s_waitcnt vmcnt(0)" ::: "memory");
  __syncthreads();
  if (threadIdx.x == 0) {
    unsigned* bar = b.bar;
    __builtin_amdgcn_s_waitcnt(0);
    unsigned nloc = b.st[0], nx = b.st[1];
    if (nloc == 0u) { xcd_barrier_complete(bar, b.x, nloc, nx); b.st[0] = nloc; b.st[1] = nx; }
    const unsigned old = xb_add(&bar[XB_XSUB(b.x)], 1u);
    const unsigned gen = old / nloc;
    if (old + 1u == (gen + 1u) * nloc) {
      __builtin_amdgcn_fence(__ATOMIC_RELEASE, "agent");
      asm volatile("s_waitcnt vmcnt(0)" ::: "memory");
      const unsigned og = xb_add(&bar[XB_TOP], 1u);
      const unsigned tg = og / nx;
      if (og + 1u == (tg + 1u) * nx) xb_add(&bar[XB_TOPGEN], 1u);
      else XB_SPIN(xb_ld(&bar[XB_TOPGEN]) == tg, bar);
      __builtin_amdgcn_fence(__ATOMIC_ACQUIRE, "agent");
      xb_add(&bar[XB_XGEN(b.x)], 1u);
      asm volatile("s_waitcnt vmcnt(0)" ::: "memory");
    } else {
      XB_SPIN(xb_ld(&bar[XB_XGEN(b.x)]) == gen, bar);
      __builtin_amdgcn_fence(__ATOMIC_ACQUIRE, "agent");
      asm volatile("s_waitcnt vmcnt(0)" ::: "memory");
    }
  }
  __syncthreads();
}

DI void mod_item(const Params& p, int it, char* smem) {
  const int tid = otid();
  float* sv = (float*)smem;
  float* red = sv + 5 * 1024;
  const int l = it / 144, j0 = (it % 144) * 64;
  __syncthreads();
  for (int i = tid; i < 5120; i += 256) {
    int v = i >> 10, k = i & 1023;
    float c = (v == 0) ? pin(p, I_CCTX)[k] : pin(p, I_C)[(v - 1) * 1024 + k];
    sv[i] = c / (1.f + expf(-c));
  }
  __syncthreads();
  const int c4 = tid & 15, kg = tid >> 4;
  float acc[5][4];
#pragma unroll
  for (int v = 0; v < 5; ++v)
#pragma unroll
    for (int i = 0; i < 4; ++i) acc[v][i] = 0.f;
  const float* w = pin(p, I_WADA) + (size_t)l * 1024 * NMOD + j0 + c4 * 4;
#pragma unroll 1
  for (int k0 = kg; k0 < 1024; k0 += 128) {
    float4 wv[8];
#pragma unroll
    for (int u = 0; u < 8; ++u) wv[u] = *(const float4*)(w + (size_t)(k0 + 16 * u) * NMOD);
#pragma unroll
    for (int u = 0; u < 8; ++u)
#pragma unroll
      for (int v = 0; v < 5; ++v) {
        float s = sv[v * 1024 + k0 + 16 * u];
        acc[v][0] += s * wv[u].x; acc[v][1] += s * wv[u].y; acc[v][2] += s * wv[u].z; acc[v][3] += s * wv[u].w;
      }
  }
#pragma unroll
  for (int v = 0; v < 5; ++v)
#pragma unroll
    for (int i = 0; i < 4; ++i) red[(kg * 5 + v) * 64 + c4 * 4 + i] = acc[v][i];
  __syncthreads();
  for (int o = tid; o < 320; o += 256) {
    int v = o >> 6, c = o & 63;
    float s = 0.f;
    for (int k = 0; k < 16; ++k) s += red[(k * 5 + v) * 64 + c];
    s += pin(p, I_BADA)[l * NMOD + j0 + c];
    ((float*)(pws(p, OFF_MOD)))[(size_t)(l * 5 + v) * NMOD + j0 + c] = s;
  }
}

DI void filt_item(const Params& p, int it, char* smem) {
  const int tid = otid(), q = tid >> 6, tl = tid & 63;
  float* w1s = (float*)smem;
  float* w2s = w1s + 33 * 64;
  float* feats = w2s + 64 * 64;
  float* z1 = feats + 8 * 36;
  float* z2 = z1 + 8 * 64;
  const int l = it / 160, rem = it % 160;
  const float* w1 = pin(p, I_FW1) + l * 33 * 64;
  const float* b1 = pin(p, I_FB1) + l * 64;
  const float* w2 = pin(p, I_FW2) + l * 64 * 64;
  const float* b2 = pin(p, I_FB2) + l * 64;
  const float* w3 = pin(p, I_FW3) + l * 64 * 256;
  const float* b3 = pin(p, I_FB3) + l * 256;
  const float frq = pin(p, I_FFR)[l * 64 + tl];
  float* filt = (float*)(pws(p, OFF_FILT)) + (size_t)l * 1280 * 256;
  __syncthreads();
  for (int i = tid; i < 33 * 64; i += 256) w1s[i] = w1[i];
  for (int i = tid; i < 64 * 64; i += 256) w2s[i] = w2[i];
  int pidx[2], Lp[2], pos[2];
#pragma unroll
  for (int u = 0; u < 2; ++u) {
    pidx[u] = rem * 8 + q + 4 * u;
    Lp[u] = pidx[u] < 256 ? 256 : 1024;
    pos[u] = pidx[u] < 256 ? pidx[u] : pidx[u] - 256;
    if (tl < 33) {
      float f;
      if (tl == 0) f = (float)pos[u] / (float)(Lp[u] - 1);
      else {
        int j = (tl - 1) & 15;
        float fj = 1e-4f + (float)j * ((15.0f - 1e-4f) / 15.0f);
        float ang = (6.283185307179586f / (float)Lp[u]) * (float)pos[u] * fj;
        f = (tl <= 16) ? cosf(ang) : -sinf(ang);
      }
      feats[(q + 4 * u) * 36 + tl] = f;
    }
  }
  __syncthreads();
  {
    float s0 = b1[tl], s1 = s0;
#pragma unroll 3
    for (int j = 0; j < 33; ++j) {
      float w = w1s[j * 64 + tl];
      s0 += feats[q * 36 + j] * w;
      s1 += feats[(q + 4) * 36 + j] * w;
    }
    z1[q * 64 + tl] = sinf(frq * s0);
    z1[(q + 4) * 64 + tl] = sinf(frq * s1);
  }
  __syncthreads();
  {
    float s0 = b2[tl], s1 = s0;
#pragma unroll 4
    for (int j = 0; j < 64; ++j) {
      float w = w2s[j * 64 + tl];
      s0 += z1[q * 64 + j] * w;
      s1 += z1[(q + 4) * 64 + j] * w;
    }
    z2[q * 64 + tl] = sinf(frq * s0);
    z2[(q + 4) * 64 + tl] = sinf(frq * s1);
  }
  __syncthreads();
  float dist[2];
#pragma unroll
  for (int u = 0; u < 2; ++u) {
    const int centre = Lp[u] / 2;
    dist[u] = fabsf((float)(pos[u] - centre)) / (float)centre;
  }
#pragma unroll 1
  for (int cc = 0; cc < 4; ++cc) {
    const int c = tl + 64 * cc;
    float s0 = b3[c], s1 = s0;
#pragma unroll 1
    for (int j0 = 0; j0 < 64; j0 += 16) {
      float w[16];
#pragma unroll
      for (int j = 0; j < 16; ++j) w[j] = w3[(j0 + j) * 256 + c];
#pragma unroll
      for (int j = 0; j < 16; ++j) {
        s0 += z2[q * 64 + j0 + j] * w[j];
        s1 += z2[(q + 4) * 64 + j0 + j] * w[j];
      }
    }
    const float a = -3.0701134573253944f, b = -15.350567286626972f;
    const float delta = fabsf(a + (float)c * ((b - a) / 255.0f));
    filt[(size_t)pidx[0] * 256 + c] = s0 * expf(-dist[0] * delta);
    filt[(size_t)pidx[1] * 256 + c] = s1 * expf(-dist[1] * delta);
  }
}

struct ConvT {
  const float* src;
  bf16_t* dst;
  int K, N, k0, n0, gu;
};
DI ConvT conv_decode(const Params& p, int l, int idx) {
  bf16_t* wt = (bf16_t*)(pws(p, OFF_WT));
  int t = idx, which, K, N, nNt, gu;
  size_t dsto;
  if (t < 704) { which = I_W1G; K = DM; N = DFF; nNt = 44; dsto = WT_GU1; gu = 1; }
  else if ((t -= 704) < 704) { which = I_W1U; K = DM; N = DFF; nNt = 44; dsto = WT_GU1; gu = 2; }
  else if ((t -= 704) < 704) { which = I_W1D; K = DFF; N = DM; nNt = 16; dsto = WT_D1; gu = 0; }
  else if ((t -= 704) < 720) { which = I_WIN; K = DM; N = NIN; nNt = 45; dsto = WT_IN; gu = 0; }
  else if ((t -= 720) < 256) { which = I_WOUT; K = DM; N = DM; nNt = 16; dsto = WT_OUT; gu = 0; }
  else if ((t -= 256) < 704) { which = I_W2G; K = DM; N = DFF; nNt = 44; dsto = WT_GU2; gu = 1; }
  else if ((t -= 704) < 704) { which = I_W2U; K = DM; N = DFF; nNt = 44; dsto = WT_GU2; gu = 2; }
  else { t -= 704; which = I_W2D; K = DFF; N = DM; nNt = 16; dsto = WT_D2; gu = 0; }
  ConvT c;
  c.src = pin(p, which) + (size_t)l * K * N;
  c.dst = wt + dsto;
  c.K = K; c.N = N; c.k0 = (t / nNt) * 64; c.n0 = (t % nNt) * 64; c.gu = gu;
  return c;
}
DI void conv_load(const ConvT& c, int tid, float4 v[4]) {
#pragma unroll
  for (int i = 0; i < 4; ++i) {
    int r = (tid >> 4) + 16 * i, c4 = (tid & 15) * 4;
    v[i] = make_float4(0.f, 0.f, 0.f, 0.f);
    if (c.n0 + c4 < c.N) v[i] = *(const float4*)(c.src + (size_t)(c.k0 + r) * c.N + c.n0 + c4);
  }
}
DI void convert_layer(const Params& p, int l, char* smem) {
  const int tid = otid();
  float* tile = (float*)smem;
  int idx = obid();
  if (idx >= 5200) return;
  ConvT cur = conv_decode(p, l, idx);
  float4 v[4];
  conv_load(cur, tid, v);
  while (true) {
    __syncthreads();
#pragma unroll
    for (int i = 0; i < 4; ++i) {
      int r = (tid >> 4) + 16 * i, c4 = (tid & 15) * 4;
      tile[r * 65 + c4 + 0] = v[i].x; tile[r * 65 + c4 + 1] = v[i].y; tile[r * 65 + c4 + 2] = v[i].z; tile[r * 65 + c4 + 3] = v[i].w;
    }
    const int nxt = idx + gridDim.x;
    ConvT nx = cur;
    if (nxt < 5200) {
      nx = conv_decode(p, l, nxt);
      conv_load(nx, tid, v);
    }
    __syncthreads();
    const int n = tid >> 2, kq = tid & 3;
    if (cur.n0 + n < cur.N) {
      int nn = cur.n0 + n;
      int drow = (cur.gu == 0) ? nn : ((nn >> 5) * 64 + (cur.gu - 1) * 32 + (nn & 31));
      unsigned pk[8];
#pragma unroll
      for (int i = 0; i < 8; ++i)
        pk[i] = pack2(tile[(kq * 16 + 2 * i) * 65 + n], tile[(kq * 16 + 2 * i + 1) * 65 + n]);
      uint4* d = (uint4*)(cur.dst + (size_t)drow * cur.K + cur.k0 + kq * 16);
      d[0] = make_uint4(pk[0], pk[1], pk[2], pk[3]);
      d[1] = make_uint4(pk[4], pk[5], pk[6], pk[7]);
    }
    if (nxt >= 5200) break;
    idx = nxt;
    cur = nx;
  }
}

DI void phase_prologue(const Params& p, char* smem) {
  const int nb = gridDim.x, b = obid(), tid = otid();
  for (int it = b; it < 288; it += nb) mod_item(p, it, smem);
  for (int it = nb - 1 - b; it < 320; it += nb) filt_item(p, it, smem);
  {
    float* cosT = (float*)(pws(p, OFF_ROPE));
    float* sinT = cosT + 32768;
    for (int i = b * 256 + tid; i < 32768; i += nb * 256) {
      int t = i >> 5, e = i & 31;
      float pos = (e < 16) ? (float)(t >> 6) : (float)(t & 63);
      float inv = powf(10000.0f, -(float)(e & 15) / 16.0f);
      float ang = pos * inv;
      cosT[i] = cosf(ang);
      sinT[i] = sinf(ang);
    }
  }
  convert_layer(p, 0, smem);
}

DI void phase_norm(const Params& p, int l, bool from_input, const float* g, int part_shift, int part_scale) {
  const int lane = otid() & 63, wid = otid() >> 6;
  const float* modl = (const float*)(pws(p, OFF_MOD)) + (size_t)l * 5 * NMOD;
  bf16_t* H = (bf16_t*)(pws(p, OFF_H));
  const float* X = (const float*)(pws(p, OFF_X));
  for (int row = obid() * 4 + wid; row < NTOK; row += gridDim.x * 4) {
    const float* xr = from_input ? (row < NCTX ? pin(p, I_XP) + (size_t)row * DM : pin(p, I_XS) + (size_t)(row - NCTX) * DM)
                                 : X + (size_t)row * DM;
    float4 v[4];
    float ss = 0.f;
#pragma unroll
    for (int i = 0; i < 4; ++i) {
      v[i] = ((const float4*)xr)[lane + 64 * i];
      ss += v[i].x * v[i].x + v[i].y * v[i].y + v[i].z * v[i].z + v[i].w * v[i].w;
    }
    ss = wave_sum(ss);
    const float r = rsqrtf(ss * (1.0f / DM) + EPS);
    const float* mrow = modl + (size_t)mod_index(row) * NMOD;
#pragma unroll
    for (int i = 0; i < 4; ++i) {
      int c = 4 * (lane + 64 * i);
      float4 gg = *(const float4*)(g + c);
      float4 sc = *(const float4*)(mrow + part_scale * 1024 + c);
      float4 sh = *(const float4*)(mrow + part_shift * 1024 + c);
      float o0 = v[i].x * r * gg.x * (1.f + sc.x) + sh.x;
      float o1 = v[i].y * r * gg.y * (1.f + sc.y) + sh.y;
      float o2 = v[i].z * r * gg.z * (1.f + sc.z) + sh.z;
      float o3 = v[i].w * r * gg.w * (1.f + sc.w) + sh.w;
      *(uint2*)(H + (size_t)row * DM + c) = make_uint2(pack2(o0, o1), pack2(o2, o3));
    }
  }
}

DI void phase_final_norm(const Params& p) {
  const int lane = otid() & 63, wid = otid() >> 6;
  const float* X = (const float*)(pws(p, OFF_X));
  const float* g = pin(p, I_GFIN);
  for (int row = obid() * 4 + wid; row < NTOK; row += gridDim.x * 4) {
    const float* xr = X + (size_t)row * DM;
    float4 v[4];
    float ss = 0.f;
#pragma unroll
    for (int i = 0; i < 4; ++i) {
      v[i] = ((const float4*)xr)[lane + 64 * i];
      ss += v[i].x * v[i].x + v[i].y * v[i].y + v[i].z * v[i].z + v[i].w * v[i].w;
    }
    ss = wave_sum(ss);
    const float r = rsqrtf(ss * (1.0f / DM) + EPS);
#pragma unroll
    for (int i = 0; i < 4; ++i) {
      int c = 4 * (lane + 64 * i);
      float4 gg = *(const float4*)(g + c);
      float4 o = make_float4(v[i].x * r * gg.x, v[i].y * r * gg.y, v[i].z * r * gg.z, v[i].w * r * gg.w);
      *(float4*)(pout(p) + O_Y + (size_t)row * DM + c) = o;
    }
  }
}

enum { EPI_GU = 0, EPI_RES = 1, EPI_U = 2 };
struct EpiArgs {
  void* out;
  const float* xin0;
  const float* xin1;
  const float* modp;
  float coef;
};

using f32x16 = __attribute__((ext_vector_type(16))) float;
#define MFMA32(a, b, c) __builtin_amdgcn_mfma_f32_32x32x16_bf16((a), (b), (c), 0, 0, 0)

template <int EPI>
DI void gemm_phase(const bf16_t* __restrict__ A, int lda, const bf16_t* __restrict__ Bt, int ldb, int M, int N, int K,
                   const EpiArgs ea, char* smem, int tile_lo = 0, int tile_hi = 1 << 30) {
  const int tid = otid(), lane = tid & 63, r32 = lane & 31, h = lane >> 5;
  const int wid = __builtin_amdgcn_readfirstlane(tid >> 6);
  const int wn = wid & 1, kh = wid >> 1;
  const int nM = M / 128, nN = (N + 127) / 128, ntiles = (nM * nN < tile_hi) ? nM * nN : tile_hi, nk = K / 32;
  const int lrow = tid >> 2;
  const int lkc = ((tid & 3) ^ ((tid >> 4) & 3)) * 8;
  const int fsw = ((kh * 2 + h) ^ ((r32 >> 2) & 3)) * 16;
  const int aoff = r32 * 64 + fsw;
  const int aoffk = aoff + kh * 4096, aoffg = aoff + (1 - kh) * 4096;
  const int boff = 8192 + (wn * 64 + r32) * 64 + fsw;
#define GEMM_ISSUE(kt_)                                                                                              \
  do {                                                                                                               \
    char* st_ = smem + ((kt_) & 3) * 16384 + wid * 1024;                                                             \
    const unsigned ko_ = (unsigned)(kt_) * 64u;                                                                      \
    __builtin_amdgcn_global_load_lds((const unsigned*)((const char*)A + (ao0 + ko_)), (unsigned*)(st_), 16, 0, 0);   \
    __builtin_amdgcn_global_load_lds((const unsigned*)((const char*)A + (ao1 + ko_)), (unsigned*)(st_ + 4096), 16, 0, 0); \
    __builtin_amdgcn_global_load_lds((const unsigned*)((const char*)Bt + (bo0 + ko_)), (unsigned*)(st_ + 8192), 16, 0, 0); \
    __builtin_amdgcn_global_load_lds((const unsigned*)((const char*)Bt + (bo1 + ko_)), (unsigned*)(st_ + 12288), 16, 0, 0); \
  } while (0)
#define GEMM_ADDR(tile_)                                                                                             \
  do {                                                                                                               \
    m0 = ((tile_) % nM) * 128;                                                                                       \
    n0 = ((tile_) / nM) * 128;                                                                                       \
    ao0 = (unsigned)((m0 + lrow) * lda + lkc) * 2u;                                                                  \
    ao1 = ao0 + (unsigned)(64 * lda) * 2u;                                                                           \
    int br0_ = n0 + lrow, br1_ = n0 + lrow + 64;                                                                     \
    br0_ = br0_ < N ? br0_ : N - 1;                                                                                  \
    br1_ = br1_ < N ? br1_ : N - 1;                                                                                  \
    bo0 = (unsigned)(br0_ * ldb + lkc) * 2u;                                                                         \
    bo1 = (unsigned)(br1_ * ldb + lkc) * 2u;                                                                         \
  } while (0)
  int tile = tile_lo + obid();
  int m0 = 0, n0 = 0;
  unsigned ao0 = 0, ao1 = 0, bo0 = 0, bo1 = 0;
  if (tile < ntiles) {
    GEMM_ADDR(tile);
    GEMM_ISSUE(0);
    GEMM_ISSUE(1);
    GEMM_ISSUE(2);
  }
  while (tile < ntiles) {
    f32x16 acc[4][2];
#pragma unroll
    for (int i = 0; i < 4; ++i)
#pragma unroll
      for (int j = 0; j < 2; ++j)
#pragma unroll
        for (int r = 0; r < 16; ++r) acc[i][j][r] = 0.f;
    for (int kt = 0; kt < nk; ++kt) {
      if (kt + 2 < nk) asm volatile("s_waitcnt vmcnt(8)" ::: "memory");
      else if (kt + 1 < nk) asm volatile("s_waitcnt vmcnt(4)" ::: "memory");
      else asm volatile("s_waitcnt vmcnt(0)" ::: "memory");
      asm volatile("s_waitcnt lgkmcnt(0)" ::: "memory");
      __builtin_amdgcn_s_barrier();
      if (kt + 3 < nk) GEMM_ISSUE(kt + 3);
      const char* st = smem + (kt & 3) * 16384;
      bf16x8 af[4], bfr[2];
#pragma unroll
      for (int i = 0; i < 4; ++i) af[i] = *(const bf16x8*)(st + ((i < 2) ? aoffk : aoffg) + (i & 1) * 2048);
#pragma unroll
      for (int j = 0; j < 2; ++j) bfr[j] = *(const bf16x8*)(st + boff + j * 2048);
#pragma unroll
      for (int i = 0; i < 4; ++i)
#pragma unroll
        for (int j = 0; j < 2; ++j) acc[i][j] = MFMA32(af[i], bfr[j], acc[i][j]);
    }
    asm volatile("s_waitcnt lgkmcnt(0)" ::: "memory");
    __builtin_amdgcn_s_barrier();
    {
      float* mine = (float*)(smem + wid * 16384);
      const float* theirs = (const float*)(smem + (wid ^ 2) * 16384);
#pragma unroll
      for (int i = 0; i < 2; ++i)
#pragma unroll
        for (int j = 0; j < 2; ++j)
#pragma unroll
          for (int r = 0; r < 16; ++r) mine[((i * 2 + j) * 16 + r) * 64 + lane] = acc[2 + i][j][r];
      __syncthreads();
#pragma unroll
      for (int i = 0; i < 2; ++i)
#pragma unroll
        for (int j = 0; j < 2; ++j) {
#pragma unroll
          for (int r = 0; r < 16; ++r) acc[i][j][r] += theirs[((i * 2 + j) * 16 + r) * 64 + lane];
          asm volatile("" ::: "memory");
        }
      asm volatile("s_waitcnt lgkmcnt(0)" ::: "memory");
      __builtin_amdgcn_s_barrier();
    }
    const int em0 = m0, en0 = n0;
    tile += gridDim.x;
    if (tile < ntiles) {
      GEMM_ADDR(tile);
      GEMM_ISSUE(0);
      GEMM_ISSUE(1);
      GEMM_ISSUE(2);
    }
    const int rbase = em0 + 2 * kh * 32 + 4 * h;
    if (EPI == EPI_GU) {
      bf16_t* act = (bf16_t*)ea.out + (size_t)rbase * DFF + ((en0 + wn * 64) >> 1) + r32;
#pragma unroll
      for (int mi = 0; mi < 2; ++mi)
#pragma unroll
        for (int rq = 0; rq < 4; ++rq) {
#pragma unroll
          for (int rr = 0; rr < 4; ++rr) {
            const int r = rq * 4 + rr;
            const float gt = acc[mi][0][r], up = acc[mi][1][r];
            act[(size_t)(mi * 32 + rr + 8 * rq) * DFF] = f2bf(gt / (1.f + __expf(-gt)) * up);
          }
          asm volatile("" ::: "memory");
        }
    } else if (EPI == EPI_RES) {
      float* X = (float*)ea.out + (size_t)rbase * DM + en0 + wn * 64 + r32;
      const float* xr = (em0 < NCTX ? ea.xin0 + (size_t)rbase * DM : ea.xin1 + (size_t)(rbase - NCTX) * DM) + en0 + wn * 64 + r32;
      const float* mr = ea.modp + (size_t)mod_index(em0) * NMOD + en0 + wn * 64 + r32;
      const float g0 = ea.coef * mr[0], g1 = ea.coef * mr[32];
#pragma unroll
      for (int mi = 0; mi < 2; ++mi)
#pragma unroll
        for (int rq = 0; rq < 4; ++rq) {
#pragma unroll
          for (int rr = 0; rr < 4; ++rr) {
            const int r = rq * 4 + rr;
            const size_t ro = (size_t)(mi * 32 + rr + 8 * rq) * DM;
            const float x0 = xr[ro], x1 = xr[ro + 32];
            X[ro] = x0 + g0 * acc[mi][0][r];
            X[ro + 32] = x1 + g1 * acc[mi][1][r];
          }
          asm volatile("" ::: "memory");
        }
    } else {
      float* U = (float*)ea.out + (size_t)rbase * NIN + en0 + wn * 64 + r32;
      const bool ok0 = en0 + wn * 64 + r32 < N, ok1 = en0 + wn * 64 + 32 + r32 < N;
#pragma unroll
      for (int mi = 0; mi < 2; ++mi)
#pragma unroll
        for (int rq = 0; rq < 4; ++rq) {
#pragma unroll
          for (int rr = 0; rr < 4; ++rr) {
            const int r = rq * 4 + rr;
            const size_t ro = (size_t)(mi * 32 + rr + 8 * rq) * NIN;
            if (ok0) U[ro] = acc[mi][0][r];
            if (ok1) U[ro + 32] = acc[mi][1][r];
          }
          asm volatile("" ::: "memory");
        }
    }
    asm volatile("s_waitcnt vmcnt(0)" ::: "memory");
  }
#undef GEMM_ISSUE
#undef GEMM_ADDR
}

template <int EPI>
DI void gemm_k64(const bf16_t* __restrict__ A, int lda, const bf16_t* __restrict__ Bt, int ldb, int M, int N, int K,
                   const EpiArgs ea, char* smem, int tile_lo = 0, int tile_hi = 1 << 30) {
  const int tid = otid(), lane = tid & 63, r32 = lane & 31, h = lane >> 5;
  const int wid = __builtin_amdgcn_readfirstlane(tid >> 6);
  const int wn = wid & 1, kh = wid >> 1;
  const int nM = M / 128, nN = (N + 127) / 128, ntiles = (nM * nN < tile_hi) ? nM * nN : tile_hi, nk = K / 64;
  const int lrow = tid >> 3;
  const int lkc = ((tid & 7) ^ ((tid >> 4) & 7)) * 8;
  const int fsw0 = ((kh * 4 + h) ^ ((r32 >> 1) & 7)) * 16, fsw1 = ((kh * 4 + 2 + h) ^ ((r32 >> 1) & 7)) * 16;
  const int aoffk = r32 * 128 + kh * 8192, aoffg = r32 * 128 + (1 - kh) * 8192;
  const int boff = 16384 + (wn * 64 + r32) * 128;
#define GEMM_ISSUE(kt_)                                                                                              \
  do {                                                                                                               \
    char* st_ = smem + ((kt_) & 1) * 32768 + wid * 1024;                                                             \
    const unsigned ko_ = (unsigned)(kt_) * 128u;                                                                     \
    _Pragma("unroll") for (int i_ = 0; i_ < 4; ++i_)                                                                 \
      __builtin_amdgcn_global_load_lds((const unsigned*)((const char*)A + (ao0 + i_ * ao32 + ko_)),                  \
                                       (unsigned*)(st_ + i_ * 4096), 16, 0, 0);                                      \
    _Pragma("unroll") for (int i_ = 0; i_ < 4; ++i_)                                                                 \
      __builtin_amdgcn_global_load_lds((const unsigned*)((const char*)Bt + (bo[i_] + ko_)),                          \
                                       (unsigned*)(st_ + 16384 + i_ * 4096), 16, 0, 0);                              \
  } while (0)
#define GEMM_ADDR(tile_)                                                                                             \
  do {                                                                                                               \
    m0 = ((tile_) % nM) * 128;                                                                                       \
    n0 = ((tile_) / nM) * 128;                                                                                       \
    ao0 = (unsigned)((m0 + lrow) * lda + lkc) * 2u;                                                                  \
    _Pragma("unroll") for (int i_ = 0; i_ < 4; ++i_) {                                                               \
      int br_ = n0 + lrow + 32 * i_;                                                                                 \
      br_ = br_ < N ? br_ : N - 1;                                                                                   \
      bo[i_] = (unsigned)(br_ * ldb + lkc) * 2u;                                                                     \
    }                                                                                                                \
  } while (0)
  const unsigned ao32 = (unsigned)(32 * lda) * 2u;
  int tile = tile_lo + obid();
  int m0 = 0, n0 = 0;
  unsigned ao0 = 0, bo[4] = {0, 0, 0, 0};
  if (tile < ntiles) {
    GEMM_ADDR(tile);
    GEMM_ISSUE(0);
  }
  while (tile < ntiles) {
    f32x16 acc[4][2];
#pragma unroll
    for (int i = 0; i < 4; ++i)
#pragma unroll
      for (int j = 0; j < 2; ++j)
#pragma unroll
        for (int r = 0; r < 16; ++r) acc[i][j][r] = 0.f;
    for (int kt = 0; kt < nk; ++kt) {
      asm volatile("s_waitcnt vmcnt(0)" ::: "memory");
      asm volatile("s_waitcnt lgkmcnt(0)" ::: "memory");
      __builtin_amdgcn_s_barrier();
      if (kt + 1 < nk) GEMM_ISSUE(kt + 1);
      const char* st = smem + (kt & 1) * 32768;
#pragma unroll
      for (int ks = 0; ks < 2; ++ks) {
        const int fsw = ks ? fsw1 : fsw0;
        bf16x8 af[4], bfr[2];
#pragma unroll
        for (int i = 0; i < 4; ++i) af[i] = *(const bf16x8*)(st + ((i < 2) ? aoffk : aoffg) + (i & 1) * 4096 + fsw);
#pragma unroll
        for (int j = 0; j < 2; ++j) bfr[j] = *(const bf16x8*)(st + boff + j * 4096 + fsw);
#pragma unroll
        for (int i = 0; i < 4; ++i)
#pragma unroll
          for (int j = 0; j < 2; ++j) acc[i][j] = MFMA32(af[i], bfr[j], acc[i][j]);
      }
    }
    asm volatile("s_waitcnt lgkmcnt(0)" ::: "memory");
    __builtin_amdgcn_s_barrier();
    {
      float* mine = (float*)(smem + wid * 16384);
      const float* theirs = (const float*)(smem + (wid ^ 2) * 16384);
#pragma unroll
      for (int i = 0; i < 2; ++i)
#pragma unroll
        for (int j = 0; j < 2; ++j)
#pragma unroll
          for (int r = 0; r < 16; ++r) mine[((i * 2 + j) * 16 + r) * 64 + lane] = acc[2 + i][j][r];
      __syncthreads();
#pragma unroll
      for (int i = 0; i < 2; ++i)
#pragma unroll
        for (int j = 0; j < 2; ++j) {
#pragma unroll
          for (int r = 0; r < 16; ++r) acc[i][j][r] += theirs[((i * 2 + j) * 16 + r) * 64 + lane];
          asm volatile("" ::: "memory");
        }
      asm volatile("s_waitcnt lgkmcnt(0)" ::: "memory");
      __builtin_amdgcn_s_barrier();
    }
    const int em0 = m0, en0 = n0;
    tile += gridDim.x;
    if (tile < ntiles) {
      GEMM_ADDR(tile);
      GEMM_ISSUE(0);
    }
    const int rbase = em0 + 2 * kh * 32 + 4 * h;
    if (EPI == EPI_GU) {
      bf16_t* act = (bf16_t*)ea.out + (size_t)rbase * DFF + ((en0 + wn * 64) >> 1) + r32;
#pragma unroll
      for (int mi = 0; mi < 2; ++mi)
#pragma unroll
        for (int rq = 0; rq < 4; ++rq) {
#pragma unroll
          for (int rr = 0; rr < 4; ++rr) {
            const int r = rq * 4 + rr;
            const float gt = acc[mi][0][r], up = acc[mi][1][r];
            act[(size_t)(mi * 32 + rr + 8 * rq) * DFF] = f2bf(gt / (1.f + __expf(-gt)) * up);
          }
          asm volatile("" ::: "memory");
        }
    } else if (EPI == EPI_RES) {
      float* X = (float*)ea.out + (size_t)rbase * DM + en0 + wn * 64 + r32;
      const float* xr = (em0 < NCTX ? ea.xin0 + (size_t)rbase * DM : ea.xin1 + (size_t)(rbase - NCTX) * DM) + en0 + wn * 64 + r32;
      const float* mr = ea.modp + (size_t)mod_index(em0) * NMOD + en0 + wn * 64 + r32;
      const float g0 = ea.coef * mr[0], g1 = ea.coef * mr[32];
#pragma unroll
      for (int mi = 0; mi < 2; ++mi)
#pragma unroll
        for (int rq = 0; rq < 4; ++rq) {
#pragma unroll
          for (int rr = 0; rr < 4; ++rr) {
            const int r = rq * 4 + rr;
            const size_t ro = (size_t)(mi * 32 + rr + 8 * rq) * DM;
            const float x0 = xr[ro], x1 = xr[ro + 32];
            X[ro] = x0 + g0 * acc[mi][0][r];
            X[ro + 32] = x1 + g1 * acc[mi][1][r];
          }
          asm volatile("" ::: "memory");
        }
    } else {
      float* U = (float*)ea.out + (size_t)rbase * NIN + en0 + wn * 64 + r32;
      const bool ok0 = en0 + wn * 64 + r32 < N, ok1 = en0 + wn * 64 + 32 + r32 < N;
#pragma unroll
      for (int mi = 0; mi < 2; ++mi)
#pragma unroll
        for (int rq = 0; rq < 4; ++rq) {
#pragma unroll
          for (int rr = 0; rr < 4; ++rr) {
            const int r = rq * 4 + rr;
            const size_t ro = (size_t)(mi * 32 + rr + 8 * rq) * NIN;
            if (ok0) U[ro] = acc[mi][0][r];
            if (ok1) U[ro + 32] = acc[mi][1][r];
          }
          asm volatile("" ::: "memory");
        }
    }
    asm volatile("s_waitcnt vmcnt(0)" ::: "memory");
  }
#undef GEMM_ISSUE
#undef GEMM_ADDR
}

template <int EPI>
DI void gemm_big(const bf16_t* __restrict__ A, int lda, const bf16_t* __restrict__ Bt, int ldb, int M, int N, int K,
                 const EpiArgs ea, char* smem, int tile_hi = 1 << 30) {
  const int tid = otid(), lane = tid & 63, r32 = lane & 31, h = lane >> 5;
  const int wid = __builtin_amdgcn_readfirstlane(tid >> 6);
  const int wm = wid >> 1, wn = wid & 1;
  const int nM = M / 256, nN = N / 128, ntiles = (nM * nN < tile_hi) ? nM * nN : tile_hi, nk = K / 32;
  const int lrow = tid >> 2;
  const int lkc = ((tid & 3) ^ ((tid >> 4) & 3)) * 8;
  const int sw0 = ((0 + h) ^ ((r32 >> 2) & 3)) * 16, sw1 = ((2 + h) ^ ((r32 >> 2) & 3)) * 16;
  const int arow = (wm * 128 + r32) * 64;
  const int brow = 16384 + (wn * 64 + r32) * 64;
#define BIG_ISSUE(kt_, st_i)                                                                                         \
  do {                                                                                                               \
    char* st_ = smem + (st_i) * 24576 + wid * 1024;                                                                  \
    const unsigned ko_ = (unsigned)(kt_) * 64u;                                                                      \
    __builtin_amdgcn_global_load_lds((const unsigned*)((const char*)A + (ao0 + ko_)), (unsigned*)(st_), 16, 0, 0);   \
    __builtin_amdgcn_global_load_lds((const unsigned*)((const char*)A + (ao0 + ao64 + ko_)), (unsigned*)(st_ + 4096), 16, 0, 0); \
    __builtin_amdgcn_global_load_lds((const unsigned*)((const char*)A + (ao0 + 2 * ao64 + ko_)), (unsigned*)(st_ + 8192), 16, 0, 0); \
    __builtin_amdgcn_global_load_lds((const unsigned*)((const char*)A + (ao0 + 3 * ao64 + ko_)), (unsigned*)(st_ + 12288), 16, 0, 0); \
    __builtin_amdgcn_global_load_lds((const unsigned*)((const char*)Bt + (bo0 + ko_)), (unsigned*)(st_ + 16384), 16, 0, 0); \
    __builtin_amdgcn_global_load_lds((const unsigned*)((const char*)Bt + (bo0 + bo64 + ko_)), (unsigned*)(st_ + 20480), 16, 0, 0); \
  } while (0)
#define BIG_ADDR(tile_)                                                                                              \
  do {                                                                                                               \
    m0 = ((tile_) % nM) * 256;                                                                                       \
    n0 = ((tile_) / nM) * 128;                                                                                       \
    ao0 = (unsigned)((m0 + lrow) * lda + lkc) * 2u;                                                                  \
    bo0 = (unsigned)((n0 + lrow) * ldb + lkc) * 2u;                                                                  \
  } while (0)
  const unsigned ao64 = (unsigned)(64 * lda) * 2u, bo64 = (unsigned)(64 * ldb) * 2u;
  int tile = obid();
  int m0 = 0, n0 = 0;
  unsigned ao0 = 0, bo0 = 0;
  if (tile < ntiles) {
    BIG_ADDR(tile);
    BIG_ISSUE(0, 0);
    BIG_ISSUE(1, 1);
  }
  while (tile < ntiles) {
    f32x16 acc[4][2];
#pragma unroll
    for (int i = 0; i < 4; ++i)
#pragma unroll
      for (int j = 0; j < 2; ++j)
#pragma unroll
        for (int r = 0; r < 16; ++r) acc[i][j][r] = 0.f;
    int sc = 0;
    for (int kt = 0; kt < nk; ++kt) {
      if (kt + 1 < nk) asm volatile("s_waitcnt vmcnt(6)" ::: "memory");
      else asm volatile("s_waitcnt vmcnt(0)" ::: "memory");
      asm volatile("s_waitcnt lgkmcnt(0)" ::: "memory");
      __builtin_amdgcn_s_barrier();
      if (kt + 2 < nk) {
        const int sn = sc == 0 ? 2 : sc - 1;
        BIG_ISSUE(kt + 2, sn);
      }
      const char* st = smem + sc * 24576;
      {
        bf16x8 af[4], bfr[2];
#pragma unroll
        for (int i = 0; i < 4; ++i) af[i] = *(const bf16x8*)(st + arow + i * 2048 + sw0);
#pragma unroll
        for (int j = 0; j < 2; ++j) bfr[j] = *(const bf16x8*)(st + brow + j * 2048 + sw0);
#pragma unroll
        for (int i = 0; i < 4; ++i)
#pragma unroll
          for (int j = 0; j < 2; ++j) acc[i][j] = MFMA32(af[i], bfr[j], acc[i][j]);
      }
      {
        bf16x8 af[4], bfr[2];
#pragma unroll
        for (int i = 0; i < 4; ++i) af[i] = *(const bf16x8*)(st + arow + i * 2048 + sw1);
#pragma unroll
        for (int j = 0; j < 2; ++j) bfr[j] = *(const bf16x8*)(st + brow + j * 2048 + sw1);
#pragma unroll
        for (int i = 0; i < 4; ++i)
#pragma unroll
          for (int j = 0; j < 2; ++j) acc[i][j] = MFMA32(af[i], bfr[j], acc[i][j]);
      }
      sc = sc == 2 ? 0 : sc + 1;
    }
    asm volatile("s_waitcnt lgkmcnt(0)" ::: "memory");
    __builtin_amdgcn_s_barrier();
    const int em0 = m0, en0 = n0;
    tile += gridDim.x;
    if (tile < ntiles) {
      BIG_ADDR(tile);
      BIG_ISSUE(0, 0);
      BIG_ISSUE(1, 1);
    }
    const int rbase = em0 + wm * 128 + 4 * h;
    if (EPI == EPI_GU) {
      bf16_t* act = (bf16_t*)ea.out + (size_t)rbase * DFF + ((en0 + wn * 64) >> 1) + r32;
#pragma unroll
      for (int mt = 0; mt < 4; ++mt)
#pragma unroll
        for (int rq = 0; rq < 4; ++rq) {
#pragma unroll
          for (int rr = 0; rr < 4; ++rr) {
            const int r = rq * 4 + rr;
            const float gt = acc[mt][0][r], up = acc[mt][1][r];
            act[(size_t)(mt * 32 + rr + 8 * rq) * DFF] = f2bf(gt / (1.f + __expf(-gt)) * up);
          }
          asm volatile("" ::: "memory");
        }
    } else {
      float* X = (float*)ea.out + (size_t)rbase * DM + en0 + wn * 64 + r32;
      const float* xr = (em0 < NCTX ? ea.xin0 + (size_t)rbase * DM : ea.xin1 + (size_t)(rbase - NCTX) * DM) + en0 + wn * 64 + r32;
      const float* mr = ea.modp + (size_t)mod_index(em0) * NMOD + en0 + wn * 64 + r32;
      const float g0 = ea.coef * mr[0], g1 = ea.coef * mr[32];
#pragma unroll
      for (int mt = 0; mt < 4; ++mt)
#pragma unroll
        for (int rq = 0; rq < 4; ++rq) {
#pragma unroll
          for (int rr = 0; rr < 4; ++rr) {
            const int r = rq * 4 + rr;
            const size_t ro = (size_t)(mt * 32 + rr + 8 * rq) * DM;
            const float x0 = xr[ro], x1 = xr[ro + 32];
            X[ro] = x0 + g0 * acc[mt][0][r];
            X[ro + 32] = x1 + g1 * acc[mt][1][r];
          }
          asm volatile("" ::: "memory");
        }
    }
    asm volatile("s_waitcnt vmcnt(0)" ::: "memory");
  }
#undef BIG_ISSUE
#undef BIG_ADDR
}

DI int key_row(int t) { return t < NCTX ? t : NCTX + ((t - NCTX) >> 10) * 1280 + 256 + ((t - NCTX) & 1023); }

DI void phase_prep(const Params& p, int l) {
  const int tid = otid();
  const float* U = (const float*)(pws(p, OFF_U));
  bf16_t* QB = (bf16_t*)(pws(p, OFF_QB));
  bf16_t* QC = (bf16_t*)(pws(p, OFF_QC));
  bf16_t* KB = (bf16_t*)(pws(p, OFF_KB));
  bf16_t* VB = (bf16_t*)(pws(p, OFF_VB));
  bf16_t* KC = (bf16_t*)(pws(p, OFF_KC));
  bf16_t* VC = (bf16_t*)(pws(p, OFF_VC));
  const float* cosT = (const float*)(pws(p, OFF_ROPE));
  const float* sinT = cosT + 32768;
  const float* gq = pin(p, I_GQN) + l * 64;
  const float* gk = pin(p, I_GKN) + l * 64;
  const int gid = (obid() * 256 + tid) >> 4, ngroups = gridDim.x * 16, i16 = tid & 15;
  const int nunits = NTOK * 16;
  for (int base = 0; base < nunits; base += ngroups) {
    int unit = base + gid;
    const bool valid = unit < nunits;
    if (!valid) unit = nunits - 1;
    const int t = unit >> 4, hv = unit & 15;
    int col;
    if (hv < 4) col = 1040 + hv * 64;
    else if (hv < 6) col = 1296 + (hv - 4) * 64;
    else if (hv < 8) col = 1424 + (hv - 6) * 64;
    else if (hv < 12) col = 1552 + (hv - 8) * 64;
    else if (hv < 14) col = 1808 + (hv - 12) * 64;
    else col = 1936 + (hv - 14) * 64;
    float4 xv = *(const float4*)(U + (size_t)t * NIN + col + i16 * 4);
    float x[4] = {xv.x, xv.y, xv.z, xv.w};
    const bool lat = t >= NCTX;
    const bool do_norm = hv < 6;
    const bool is_q = (hv < 4) || (hv >= 8 && hv < 12);
    const bool is_v = (hv == 6 || hv == 7 || hv >= 14);
    float ss = x[0] * x[0] + x[1] * x[1] + x[2] * x[2] + x[3] * x[3];
    ss += shx<1>(ss); ss += shx<2>(ss); ss += shx<4>(ss); ss += shx<8>(ss);
    if (do_norm) {
      const float r = rsqrtf(ss * (1.0f / 64.0f) + EPS);
      const float* gg = (hv < 4) ? gq : gk;
#pragma unroll
      for (int j = 0; j < 4; ++j) x[j] = x[j] * r * gg[i16 * 4 + j];
    }
    if (!lat && valid && !is_q) {
      const int b = t >> 8, s = t & 255;
      size_t o;
      int kvh;
      if (hv < 6) { o = O_GK; kvh = hv - 4; }
      else if (hv < 8) { o = O_GV; kvh = hv - 6; }
      else if (hv < 14) { o = O_SK; kvh = hv - 12; }
      else { o = O_SV; kvh = hv - 14; }
      float* dst = pout(p) + o + ((size_t)((b * 2 + l) * 256 + s)) * 128 + kvh * 64 + i16 * 4;
      *(float4*)dst = make_float4(x[0], x[1], x[2], x[3]);
    }
    float xp[4];
#pragma unroll
    for (int j = 0; j < 4; ++j) xp[j] = shx<4>(x[j]);
    if (lat && !is_v) {
      const int s = (t - NCTX) & 1023;
      const bool first = (i16 & 4) == 0;
#pragma unroll
      for (int j = 0; j < 4; ++j) {
        int d = i16 * 4 + j;
        int e = (d < 32) ? (d & 15) : 16 + (d & 15);
        float cs = cosT[s * 32 + e], sn = sinT[s * 32 + e];
        x[j] = first ? (x[j] * cs - xp[j] * sn) : (x[j] * cs + xp[j] * sn);
      }
    }
    if (is_q) {
#pragma unroll
      for (int j = 0; j < 4; ++j) x[j] *= 0.125f;
    }
    if (valid) {
      uint2 pk = make_uint2(pack2(x[0], x[1]), pack2(x[2], x[3]));
      bf16_t* dst;
      if (hv < 4) dst = QB + (size_t)t * 256 + hv * 64;
      else if (hv < 6) dst = KB + (size_t)key_row(t) * 128 + (hv - 4) * 64;
      else if (hv < 8) dst = VB + (size_t)key_row(t) * 128 + (hv - 6) * 64;
      else if (hv < 12) dst = QC + (size_t)t * 256 + (hv - 8) * 64;
      else if (hv < 14) dst = KC + (size_t)key_row(t) * 128 + (hv - 12) * 64;
      else dst = VC + (size_t)key_row(t) * 128 + (hv - 14) * 64;
      *(uint2*)(dst + i16 * 4) = pk;
    }
  }
  for (int i = obid() * 256 + tid; i < 4 * 4 * 256 * 32; i += gridDim.x * 256) {
    const int which = i >> 15, rem = i & 32767;
    const int b = rem >> 13, s = (rem >> 5) & 255, c4 = (rem & 31) * 4;
    const float* srcb = (which == 0) ? pin(p, I_CGK) : (which == 1) ? pin(p, I_CGV) : (which == 2) ? pin(p, I_CSK) : pin(p, I_CSV);
    const float* src = srcb + ((size_t)((b * 2 + l) * 256 + s)) * 128 + c4;
    float4 v = *(const float4*)src;
    bf16_t* dstb = (which == 0) ? KB : (which == 1) ? VB : (which == 2) ? KC : VC;
    *(uint2*)(dstb + (size_t)(NCTX + b * 1280 + s) * 128 + c4) = make_uint2(pack2(v.x, v.y), pack2(v.z, v.w));
  }
}

DI void attn_item(const bf16_t* Q, const bf16_t* K, const bf16_t* V, int q0, int n1, int start2, int n2, bool window,
                  bool has_sink, float sink, bf16_t* Y, char* smem) {
  const int tid = otid(), lane = tid & 63, wid = tid >> 6, g = lane >> 4, r16 = lane & 15;
  bf16_t* Ks0 = (bf16_t*)smem;
  int qrow[2];
  bf16x8 qf[2][2];
  float m_run[2], l_run[2];
  f32x4 o[2][4];
#pragma unroll
  for (int u = 0; u < 2; ++u) {
    qrow[u] = q0 + wid * 32 + u * 16 + r16;
    qf[u][0] = *(const bf16x8*)(Q + (size_t)qrow[u] * 256 + g * 8);
    qf[u][1] = *(const bf16x8*)(Q + (size_t)qrow[u] * 256 + 32 + g * 8);
    m_run[u] = has_sink ? sink : -INFINITY;
    l_run[u] = (has_sink && g == 0) ? 1.f : 0.f;
#pragma unroll
    for (int i = 0; i < 4; ++i) o[u][i] = (f32x4){0.f, 0.f, 0.f, 0.f};
  }
  const int ntl = n1 + n2;
  uint4 pk[2], pv[2];
#pragma unroll
  for (int j = 0; j < 2; ++j) {
    int c = tid + 256 * j, key = c >> 3, dc = (c & 7) * 8;
    const int tile0 = n1 > 0 ? 0 : start2;
    pk[j] = *(const uint4*)(K + (size_t)(tile0 * 64 + key) * 128 + dc);
    pv[j] = *(const uint4*)(V + (size_t)(tile0 * 64 + key) * 128 + dc);
  }
  __syncthreads();
  for (int ti = 0; ti < ntl; ++ti) {
    const int tile = ti < n1 ? ti : start2 + (ti - n1);
    bf16_t* Ks = Ks0 + (ti & 1) * (2 * 64 * 72);
    bf16_t* Vt = Ks + 64 * 72;
#pragma unroll
    for (int j = 0; j < 2; ++j) {
      int c = tid + 256 * j, key = c >> 3, dc = (c & 7) * 8;
      uint4 kv = pk[j];
      *(uint4*)(Ks + key * 72 + dc) = kv;
      uint4 vv = pv[j];
      unsigned w[4] = {vv.x, vv.y, vv.z, vv.w};
#pragma unroll
      for (int i = 0; i < 4; ++i) {
        Vt[(dc + 2 * i) * 72 + key] = (bf16_t)(w[i] & 0xffffu);
        Vt[(dc + 2 * i + 1) * 72 + key] = (bf16_t)(w[i] >> 16);
      }
    }
    __syncthreads();
    if (ti + 1 < ntl) {
      const int tnext = (ti + 1) < n1 ? (ti + 1) : start2 + (ti + 1 - n1);
#pragma unroll
      for (int j = 0; j < 2; ++j) {
        int c = tid + 256 * j, key = c >> 3, dc = (c & 7) * 8;
        pk[j] = *(const uint4*)(K + (size_t)(tnext * 64 + key) * 128 + dc);
        pv[j] = *(const uint4*)(V + (size_t)(tnext * 64 + key) * 128 + dc);
      }
    }
    f32x4 s[2][4];
#pragma unroll
    for (int kt = 0; kt < 4; ++kt) {
      bf16x8 a0 = *(const bf16x8*)(Ks + (kt * 16 + r16) * 72 + g * 8);
      bf16x8 a1 = *(const bf16x8*)(Ks + (kt * 16 + r16) * 72 + 32 + g * 8);
#pragma unroll
      for (int u = 0; u < 2; ++u) {
        f32x4 z = (f32x4){0.f, 0.f, 0.f, 0.f};
        z = MFMA16(a0, qf[u][0], z);
        s[u][kt] = MFMA16(a1, qf[u][1], z);
      }
    }
    bf16x8 pb[2][2];
#pragma unroll
    for (int u = 0; u < 2; ++u) {
      if (window && tile >= 4) {
#pragma unroll
        for (int kt = 0; kt < 4; ++kt)
#pragma unroll
          for (int j = 0; j < 4; ++j) {
            int kp = (tile - 4) * 64 + kt * 16 + g * 4 + j;
            int dlt = kp - qrow[u];
            if (dlt > 128 || dlt < -128) s[u][kt][j] = -INFINITY;
          }
      }
      float mx = -INFINITY;
#pragma unroll
      for (int kt = 0; kt < 4; ++kt)
#pragma unroll
        for (int j = 0; j < 4; ++j) mx = fmaxf(mx, s[u][kt][j]);
      mx = fmaxf(mx, shx<16>(mx));
      mx = fmaxf(mx, __shfl_xor(mx, 32));
      const float m_new = fmaxf(m_run[u], mx);
      float alpha, msub;
      if (m_new == -INFINITY) { alpha = 1.f; msub = 0.f; }
      else { alpha = __expf(m_run[u] - m_new); msub = m_new; }
      float lsum = 0.f;
#pragma unroll
      for (int kt = 0; kt < 4; ++kt)
#pragma unroll
        for (int j = 0; j < 4; ++j) {
          float pe = __expf(s[u][kt][j] - msub);
          s[u][kt][j] = pe;
          lsum += pe;
        }
      l_run[u] = l_run[u] * alpha + lsum;
      m_run[u] = m_new;
#pragma unroll
      for (int i = 0; i < 4; ++i) o[u][i] *= alpha;
#pragma unroll
      for (int c = 0; c < 2; ++c) {
        unsigned* pw = (unsigned*)&pb[u][c];
        pw[0] = pack2(s[u][2 * c][0], s[u][2 * c][1]);
        pw[1] = pack2(s[u][2 * c][2], s[u][2 * c][3]);
        pw[2] = pack2(s[u][2 * c + 1][0], s[u][2 * c + 1][1]);
        pw[3] = pack2(s[u][2 * c + 1][2], s[u][2 * c + 1][3]);
      }
    }
#pragma unroll
    for (int c = 0; c < 2; ++c)
#pragma unroll
      for (int et = 0; et < 4; ++et) {
        const bf16_t* vp = Vt + (et * 16 + r16) * 72 + c * 32 + g * 4;
        bf16x4 lo = *(const bf16x4*)(vp);
        bf16x4 hi = *(const bf16x4*)(vp + 16);
        bf16x8 a = __builtin_shufflevector(lo, hi, 0, 1, 2, 3, 4, 5, 6, 7);
#pragma unroll
        for (int u = 0; u < 2; ++u) o[u][et] = MFMA16(a, pb[u][c], o[u][et]);
      }
  }
#pragma unroll
  for (int u = 0; u < 2; ++u) {
    float lt = l_run[u];
    lt += shx<16>(lt);
    lt += __shfl_xor(lt, 32);
    const float inv = 1.f / lt;
#pragma unroll
    for (int et = 0; et < 4; ++et) {
      uint2 pk2 = make_uint2(pack2(o[u][et][0] * inv, o[u][et][1] * inv), pack2(o[u][et][2] * inv, o[u][et][3] * inv));
      *(uint2*)(Y + (size_t)qrow[u] * DM + et * 16 + g * 4) = pk2;
    }
  }
}

using f32x2 = __attribute__((ext_vector_type(2))) float;
template <int NI>
DI void hyena_item(const Params& p, int l, int tok0, int cq, bf16_t* YM, char* smem) {
  constexpr int L = NI * 256;
  constexpr int NH = (NI >= 2) ? NI / 2 : 1;
  const int tid = otid(), lane = tid & 63;
  const int wid = __builtin_amdgcn_readfirstlane(tid >> 6);
  const int pr = wid & 1, hf = wid >> 1;
  const int c0 = cq * 4, ca = c0 + 2 * pr;
  f32x2* zz = (f32x2*)((float*)smem + pr * (8 * L));
  f32x2* h2 = zz + 2 * L;
  f32x2* x2 = h2 + L;
  float* raw = (float*)smem + 2 * (8 * L);
  const float* U = (const float*)(pws(p, OFF_U));
  const float* cw = pin(p, I_CW) + l * 3 * 768;
  const float* cb = pin(p, I_CB) + l * 768;
  const float* filt = (const float*)(pws(p, OFF_FILT)) + (size_t)l * 1280 * 256 + (size_t)(NI == 1 ? 0 : 256) * 256;
  f32x2 w0a, w0b, w0c, b0, w1a, w1b, w1c, b1, w2a, w2b, w2c, b2;
#pragma unroll
  for (int e = 0; e < 2; ++e) {
    const int c = ca + e;
    w0a[e] = cw[c]; w0b[e] = cw[768 + c]; w0c[e] = cw[1536 + c]; b0[e] = cb[c];
    w1a[e] = cw[256 + c]; w1b[e] = cw[768 + 256 + c]; w1c[e] = cw[1536 + 256 + c]; b1[e] = cb[256 + c];
    w2a[e] = cw[512 + c]; w2b[e] = cw[768 + 512 + c]; w2c[e] = cw[1536 + 512 + c]; b2[e] = cb[512 + c];
  }
  __syncthreads();
  {
    const f32x2 zero = {0.f, 0.f};
    for (int i = lane + 64 * hf; i < L / 2; i += 128) { zz[i] = zero; zz[3 * L / 2 + i] = zero; }
  }
  for (int s = tid; s < L; s += 256) {
    const float4 f = *(const float4*)(filt + (size_t)s * 256 + c0);
    f32x2* hA = (f32x2*)((float*)smem) + 2 * L + s;
    f32x2* hB = (f32x2*)((float*)smem + 8 * L) + 2 * L + s;
    *hA = (f32x2){f.x, f.y};
    *hB = (f32x2){f.z, f.w};
  }
#pragma unroll 1
  for (int ch = 0; ch < NI; ++ch) {
    __syncthreads();
#pragma unroll
    for (int k = 0; k < 4; ++k) {
      const int idx = tid + 256 * k;
      if (idx < 774) {
        const int reg = idx / 258, row = idx - reg * 258;
        const int t = ch * 256 - 1 + row;
        float4 v = make_float4(0.f, 0.f, 0.f, 0.f);
        if (t >= 0 && t < L) v = *(const float4*)(U + (size_t)(tok0 + t) * NIN + 2064 + reg * 256 + c0);
        *(float4*)(raw + (size_t)idx * 4) = v;
      }
    }
    __syncthreads();
#pragma unroll
    for (int k = 0; k < 2; ++k) {
      const int tl = lane + 64 * k + 128 * hf, row = tl + 1;
      const f32x2* r0 = (const f32x2*)(raw + (0 * 258 + row) * 4 + 2 * pr);
      const f32x2* r1 = (const f32x2*)(raw + (1 * 258 + row) * 4 + 2 * pr);
      const f32x2* r2 = (const f32x2*)(raw + (2 * 258 + row) * 4 + 2 * pr);
      const f32x2 x0 = b0 + w0a * r0[-2] + w0b * r0[0] + w0c * r0[2];
      const f32x2 x1 = b1 + w1a * r1[-2] + w1b * r1[0] + w1c * r1[2];
      const f32x2 vv = b2 + w2a * r2[-2] + w2b * r2[0] + w2c * r2[2];
      const int t = ch * 256 + tl;
      zz[L / 2 + t] = x1 * vv;
      x2[t] = x0;
    }
  }
  __syncthreads();
  f32x2 acc[NH][4];
  float4 hi[NH][2];
  const float4* zz4 = (const float4*)__builtin_assume_aligned(zz, 16);
  const float4* h4p = (const float4*)__builtin_assume_aligned(h2, 16);
  const int gofs = (NI >= 2) ? NH * hf : 0;
#pragma unroll
  for (int i = 0; i < NH; ++i) {
#pragma unroll
    for (int j = 0; j < 4; ++j) acc[i][j] = (f32x2){0.f, 0.f};
    const int xb = 4 * lane + 256 * (gofs + i) + L;
    hi[i][0] = zz4[xb / 2];
    hi[i][1] = zz4[xb / 2 + 1];
  }
  const bool active = (NI >= 2) || (hf == 0);
  if (active) {
    float4 lo[NH][2], hq[2];
#pragma unroll
    for (int i = 0; i < NH; ++i) {
      const int xb = 4 * lane + 256 * (gofs + i) + L - 4;
      lo[i][0] = zz4[xb / 2];
      lo[i][1] = zz4[xb / 2 + 1];
    }
    hq[0] = h4p[0];
    hq[1] = h4p[1];
#pragma unroll 2
    for (int sg = 0; sg < L / 4; ++sg) {
      const int sn = (sg + 1 < L / 4) ? sg + 1 : sg;
      float4 nlo[NH][2], nhq[2];
#pragma unroll
      for (int i = 0; i < NH; ++i) {
        const int xb = 4 * lane + 256 * (gofs + i) + L - 4 * sn - 4;
        nlo[i][0] = zz4[xb / 2];
        nlo[i][1] = zz4[xb / 2 + 1];
      }
      nhq[0] = h4p[2 * sn];
      nhq[1] = h4p[2 * sn + 1];
      const f32x2 hh[4] = {(f32x2){hq[0].x, hq[0].y}, (f32x2){hq[0].z, hq[0].w}, (f32x2){hq[1].x, hq[1].y}, (f32x2){hq[1].z, hq[1].w}};
#pragma unroll
      for (int i = 0; i < NH; ++i) {
        const float4 lo0 = lo[i][0], lo1 = lo[i][1];
        const f32x2 w[8] = {(f32x2){lo0.x, lo0.y}, (f32x2){lo0.z, lo0.w}, (f32x2){lo1.x, lo1.y}, (f32x2){lo1.z, lo1.w},
                            (f32x2){hi[i][0].x, hi[i][0].y}, (f32x2){hi[i][0].z, hi[i][0].w},
                            (f32x2){hi[i][1].x, hi[i][1].y}, (f32x2){hi[i][1].z, hi[i][1].w}};
#pragma unroll
        for (int j = 0; j < 4; ++j) {
          f32x2 a = acc[i][j];
          a = __builtin_elementwise_fma(hh[0], w[4 + j], a);
          a = __builtin_elementwise_fma(hh[1], w[3 + j], a);
          a = __builtin_elementwise_fma(hh[2], w[2 + j], a);
          a = __builtin_elementwise_fma(hh[3], w[1 + j], a);
          acc[i][j] = a;
        }
        hi[i][0] = lo0;
        hi[i][1] = lo1;
        lo[i][0] = nlo[i][0];
        lo[i][1] = nlo[i][1];
      }
      hq[0] = nhq[0];
      hq[1] = nhq[1];
    }
  }
  f32x2 hb;
  hb[0] = pin(p, I_HBIAS)[l * 256 + ca];
  hb[1] = pin(p, I_HBIAS)[l * 256 + ca + 1];
  bf16_t* obuf = (bf16_t*)raw;
  if (active) {
#pragma unroll
    for (int i = 0; i < NH; ++i)
#pragma unroll
      for (int j = 0; j < 4; ++j) {
        const int t = 4 * lane + 256 * (gofs + i) + j;
        const f32x2 y = acc[i][j] + hb * zz[t + L / 2];
        const f32x2 o = x2[t] * y;
        *(unsigned*)(obuf + t * 4 + 2 * pr) = pack2(o[0], o[1]);
      }
  }
  __syncthreads();
  for (int t = tid; t < L; t += 256)
    *(uint2*)(YM + (size_t)(tok0 + t) * DM + 768 + c0) = *(const uint2*)(obuf + t * 4);
}

constexpr int FLAG_WORD0 = 3584;
DI void mlstm_dir_item(const Params& p, int l, bool lat, int bidx, int tok0, int L, int head, int dir, int* flag, char* smem) {
  const int tid = otid(), lane = tid & 63, g = lane >> 4, r16 = lane & 15;
  const int wid = __builtin_amdgcn_readfirstlane(tid >> 6);
  bf16_t* Qs = (bf16_t*)smem;
  bf16_t* Ks = Qs + 64 * 72;
  bf16_t* Vt = Ks + 64 * 72;
  bf16_t* Ct = Vt + 64 * 72;
  float* vec = (float*)(smem + 4 * 9216);
  float* v_d1 = vec + 320;
  float* S_bc = (float*)(smem + 4 * 9216 + 4096);
  float* S_amb = S_bc + 1024;
  float* S_mt = S_amb + 1024;
  float* S_wi = S_mt + 1024;
  float* S_wk = S_wi + 1024;
  float* S_btot = S_wk + 1024;
  float* S_mx = S_btot + 16;
  float* S_dec = S_mx + 16;
  float* S_mnew = S_dec + 16;
  float* v_d2 = vec + 384;
  float* v_np = vec + 640;
  float* v_n = vec + 896;
  float* v_sc = vec + 960;
  const float* U = (const float*)(pws(p, OFF_U));
  float* HD = (float*)(pws(p, dir == 0 ? OFF_HF : OFF_HB));
  const int nc = L / 64;
  const float gbi = pin(p, I_BG)[l * 16 + dir * 4 + head];
  const float gbf = pin(p, I_BG)[l * 16 + 8 + dir * 4 + head];
  const size_t sidx = ((size_t)((bidx * 2 + l) * 2 + dir)) * 4 + head;

  f32x4 cacc[4];
  __syncthreads();
  if (lat) {
    const float* sc = pin(p, I_SC) + sidx * 4096;
#pragma unroll
    for (int et = 0; et < 4; ++et)
#pragma unroll
      for (int j = 0; j < 4; ++j) cacc[et][j] = sc[(wid * 16 + g * 4 + j) * 64 + et * 16 + r16];
    if (tid < 64) v_n[tid] = pin(p, I_SN)[sidx * 64 + tid];
    if (tid == 0) v_sc[0] = pin(p, I_SM)[sidx];
  } else {
#pragma unroll
    for (int et = 0; et < 4; ++et) cacc[et] = (f32x4){0.f, 0.f, 0.f, 0.f};
    if (tid < 64) v_n[tid] = 0.f;
    if (tid == 0) v_sc[0] = 0.f;
  }
#pragma unroll
  for (int et = 0; et < 4; ++et)
    *(uint2*)(Ct + (et * 16 + r16) * 72 + wid * 16 + g * 4) =
        make_uint2(pack2(cacc[et][0], cacc[et][1]), pack2(cacc[et][2], cacc[et][3]));

  for (int c = wid; c < nc; c += 4) {
    const int pos = c * 64 + lane;
    const int tok = tok0 + (dir == 0 ? pos : L - 1 - pos);
    const float igv = U[(size_t)tok * NIN + 1024 + dir * 4 + head] + gbi;
    const float fgv = U[(size_t)tok * NIN + 1032 + dir * 4 + head] + gbf;
    const float lf = fminf(fgv, 0.f) - __logf(1.f + __expf(-fabsf(fgv)));
    float bc = lf;
#pragma unroll
    for (int o = 1; o < 64; o <<= 1) {
      float up = __shfl_up(bc, o);
      if (lane >= o) bc += up;
    }
    const float amb = igv - bc;
    float pm = amb;
#pragma unroll
    for (int o = 1; o < 64; o <<= 1) {
      float up = __shfl_up(pm, o);
      if (lane >= o) pm = fmaxf(pm, up);
    }
    const float btot = __shfl(bc, 63);
    const float wlog = btot - bc + igv;
    float mx = wlog;
    mx = fmaxf(mx, shx<32>(mx)); mx = fmaxf(mx, shx<16>(mx)); mx = fmaxf(mx, shx<8>(mx));
    mx = fmaxf(mx, shx<4>(mx)); mx = fmaxf(mx, shx<2>(mx)); mx = fmaxf(mx, shx<1>(mx));
    S_bc[c * 64 + lane] = bc;
    S_amb[c * 64 + lane] = amb;
    S_mt[c * 64 + lane] = bc + pm;
    S_wk[c * 64 + lane] = wlog;
    if (lane == 0) { S_btot[c] = btot; S_mx[c] = mx; }
  }
  __syncthreads();
  if (wid == 0) {
    float m_old = v_sc[0];
    for (int c = 0; c < nc; ++c) {
      const float bc = S_bc[c * 64 + lane];
      const float inter = bc + m_old;
      const float mt = fmaxf(S_mt[c * 64 + lane], inter);
      const float btot = S_btot[c];
      const float m_new = fmaxf(btot + m_old, S_mx[c]);
      S_mt[c * 64 + lane] = mt;
      S_wi[c * 64 + lane] = __expf(inter - mt);
      S_wk[c * 64 + lane] = __expf(S_wk[c * 64 + lane] - m_new);
      if (lane == 0) { S_dec[c] = __expf(btot + m_old - m_new); S_mnew[c] = m_new; }
      m_old = m_new;
    }
  }
  __syncthreads();
  float4 pq[4], pk4[4], pv4[4];
#define MLSTM_FETCH(ci_)                                                                                             \
  do {                                                                                                               \
    _Pragma("unroll") for (int j = 0; j < 4; ++j) {                                                                  \
      const int cidx = tid + 256 * j, row = cidx >> 4, d4 = (cidx & 15) * 4;                                         \
      const int pos = (ci_) * 64 + row;                                                                              \
      const int tok = tok0 + (dir == 0 ? pos : L - 1 - pos);                                                         \
      const float* ur = U + (size_t)tok * NIN + head * 64 + d4;                                                      \
      pq[j] = *(const float4*)(ur);                                                                                  \
      pk4[j] = *(const float4*)(ur + 256);                                                                           \
      pv4[j] = *(const float4*)(ur + 512);                                                                           \
    }                                                                                                                \
  } while (0)
  MLSTM_FETCH(0);
  for (int ci = 0; ci < nc; ++ci) {
#pragma unroll
    for (int j = 0; j < 4; ++j) {
      const int cidx = tid + 256 * j, row = cidx >> 4, d4 = (cidx & 15) * 4;
      const float4 qv = pq[j], kv = pk4[j], vv = pv4[j];
      *(uint2*)(Qs + row * 72 + d4) = make_uint2(pack2(qv.x, qv.y), pack2(qv.z, qv.w));
      *(uint2*)(Ks + row * 72 + d4) =
          make_uint2(pack2(kv.x * 0.125f, kv.y * 0.125f), pack2(kv.z * 0.125f, kv.w * 0.125f));
      Vt[(d4 + 0) * 72 + row] = f2bf(vv.x);
      Vt[(d4 + 1) * 72 + row] = f2bf(vv.y);
      Vt[(d4 + 2) * 72 + row] = f2bf(vv.z);
      Vt[(d4 + 3) * 72 + row] = f2bf(vv.w);
    }
    if (ci + 1 < nc) MLSTM_FETCH(ci + 1);
    const float* v_bc = S_bc + ci * 64;
    const float* v_amb = S_amb + ci * 64;
    const float* v_mt = S_mt + ci * 64;
    const float* v_wi = S_wi + ci * 64;
    const float* v_wk = S_wk + ci * 64;
    __syncthreads();
    f32x4 sp[4];
    unsigned n2k[4][2], spk[4][2];
    {
      bf16x8 qa[2];
#pragma unroll
      for (int ds = 0; ds < 2; ++ds) qa[ds] = *(const bf16x8*)(Qs + (wid * 16 + r16) * 72 + ds * 32 + g * 8);
#pragma unroll
      for (int st = 0; st < 4; ++st) {
        bf16x8 kb0 = *(const bf16x8*)(Ks + (st * 16 + r16) * 72 + g * 8);
        bf16x8 kb1 = *(const bf16x8*)(Ks + (st * 16 + r16) * 72 + 32 + g * 8);
        bf16x8 cb0 = *(const bf16x8*)(Ct + (st * 16 + r16) * 72 + g * 8);
        bf16x8 cb1 = *(const bf16x8*)(Ct + (st * 16 + r16) * 72 + 32 + g * 8);
        f32x4 z = (f32x4){0.f, 0.f, 0.f, 0.f};
        z = MFMA16(qa[0], kb0, z);
        sp[st] = MFMA16(qa[1], kb1, z);
        f32x4 y = (f32x4){0.f, 0.f, 0.f, 0.f};
        y = MFMA16(qa[0], cb0, y);
        y = MFMA16(qa[1], cb1, y);
        n2k[st][0] = pack2(y[0], y[1]);
        n2k[st][1] = pack2(y[2], y[3]);
      }
    }
    {
      float s = 0.f;
#pragma unroll
      for (int d = 0; d < 16; ++d) s += bf2f(Qs[lane * 72 + wid * 16 + d]) * v_n[wid * 16 + d];
      v_d2[wid * 64 + lane] = s;
    }
#pragma unroll
    for (int j = 0; j < 4; ++j) {
      const int t = wid * 16 + g * 4 + j;
      const float bt = v_bc[t] - v_mt[t];
      float rs = 0.f;
#pragma unroll
      for (int st = 0; st < 4; ++st) {
        const int s = st * 16 + r16;
        float wgt = (s <= t) ? __expf(bt + v_amb[s]) : 0.f;
        float val = sp[st][j] * wgt;
        sp[st][j] = val;
        rs += val;
      }
      rs += shx<1>(rs); rs += shx<2>(rs); rs += shx<4>(rs); rs += shx<8>(rs);
      if (r16 == 0) v_d1[t] = rs;
    }
#pragma unroll
    for (int st = 0; st < 4; ++st) {
      spk[st][0] = pack2(sp[st][0], sp[st][1]);
      spk[st][1] = pack2(sp[st][2], sp[st][3]);
    }
    __syncthreads();
    bf16_t* Sp = Qs;
    bf16_t* KwT = Ct;
#pragma unroll
    for (int st = 0; st < 4; ++st)
#pragma unroll
      for (int j = 0; j < 4; ++j)
        Sp[(wid * 16 + g * 4 + j) * 72 + st * 16 + r16] =
            (bf16_t)((j & 1) ? (spk[st][j >> 1] >> 16) : (spk[st][j >> 1] & 0xffffu));
    {
      const int s = tid & 63, dq = (tid >> 6) * 16;
      const float wk = v_wk[s];
#pragma unroll
      for (int d8 = 0; d8 < 2; ++d8) {
        bf16x8 kk = *(const bf16x8*)(Ks + s * 72 + dq + d8 * 8);
#pragma unroll
        for (int i = 0; i < 8; ++i) KwT[(dq + d8 * 8 + i) * 72 + s] = f2bf(bf2f((bf16_t)kk[i]) * wk);
      }
    }
    const float decay = S_dec[ci];
    {
      float s = 0.f;
#pragma unroll
      for (int q = 0; q < 16; ++q) s += v_wk[wid * 16 + q] * bf2f(Ks[(wid * 16 + q) * 72 + lane]);
      v_np[wid * 64 + lane] = s;
    }
    __syncthreads();
    if (wid == 0) v_n[lane] = decay * v_n[lane] + (v_np[lane] + v_np[64 + lane]) + (v_np[128 + lane] + v_np[192 + lane]);
    {
      bf16x8 sa[2], ka[2];
#pragma unroll
      for (int ks = 0; ks < 2; ++ks) {
        sa[ks] = *(const bf16x8*)(Sp + (wid * 16 + r16) * 72 + ks * 32 + g * 8);
        ka[ks] = *(const bf16x8*)(KwT + (wid * 16 + r16) * 72 + ks * 32 + g * 8);
      }
      float wi[4], dn[4];
      int tokr[4];
#pragma unroll
      for (int j = 0; j < 4; ++j) {
        const int t = wid * 16 + g * 4 + j;
        wi[j] = v_wi[t];
        float den = v_d1[t] + wi[j] * (v_d2[t] + v_d2[64 + t] + v_d2[128 + t] + v_d2[192 + t]);
        dn[j] = 1.f / fmaxf(fabsf(den), __expf(-v_mt[t]));
        const int pos = ci * 64 + t;
        tokr[j] = tok0 + (dir == 0 ? pos : L - 1 - pos);
      }
#pragma unroll
      for (int et = 0; et < 4; ++et) {
        bf16x8 vb0 = *(const bf16x8*)(Vt + (et * 16 + r16) * 72 + g * 8);
        bf16x8 vb1 = *(const bf16x8*)(Vt + (et * 16 + r16) * 72 + 32 + g * 8);
        f32x4 z = (f32x4){0.f, 0.f, 0.f, 0.f};
        z = MFMA16(sa[0], vb0, z);
        z = MFMA16(sa[1], vb1, z);
#pragma unroll
        for (int j = 0; j < 4; ++j) {
          float n2v = __uint_as_float((j & 1) ? (n2k[et][j >> 1] & 0xffff0000u) : (n2k[et][j >> 1] << 16));
          float hv = (z[j] + wi[j] * n2v) * dn[j];
          HD[(size_t)tokr[j] * 256 + head * 64 + et * 16 + r16] = hv;
        }
        f32x4 cc = cacc[et] * decay;
        cc = MFMA16(ka[0], vb0, cc);
        cacc[et] = MFMA16(ka[1], vb1, cc);
      }
    }
    __syncthreads();
#pragma unroll
    for (int et = 0; et < 4; ++et)
      *(uint2*)(Ct + (et * 16 + r16) * 72 + wid * 16 + g * 4) =
          make_uint2(pack2(cacc[et][0], cacc[et][1]), pack2(cacc[et][2], cacc[et][3]));
  }
#undef MLSTM_FETCH
  if (!lat) {
    float* oc = pout(p) + O_NC + sidx * 4096;
#pragma unroll
    for (int et = 0; et < 4; ++et)
#pragma unroll
      for (int j = 0; j < 4; ++j) oc[(wid * 16 + g * 4 + j) * 64 + et * 16 + r16] = cacc[et][j];
    if (wid == 0) pout(p)[O_NN + sidx * 64 + lane] = v_n[lane];
    if (tid == 0) pout(p)[O_NM + sidx] = S_mnew[nc - 1];
  }
  asm volatile("s_waitcnt vmcnt(0)" ::: "memory");
  __syncthreads();
  if (tid == 0) {
    __builtin_amdgcn_fence(__ATOMIC_RELEASE, "agent");
    asm volatile("s_waitcnt vmcnt(0)" ::: "memory");
    __hip_atomic_fetch_add(flag, 1, __ATOMIC_RELAXED, __HIP_MEMORY_SCOPE_AGENT);
  }
}

DI void mlstm_combine_item(const Params& p, int l, int tok0, int head, int* flag, bf16_t* YM) {
  const int tid = otid();
  if (tid == 0) {
    unsigned spins = 0;
    while (__hip_atomic_load(flag, __ATOMIC_RELAXED, __HIP_MEMORY_SCOPE_AGENT) < 2) {
      __builtin_amdgcn_s_sleep(2);
      if (++spins > (1u << 22)) break;
    }
    __builtin_amdgcn_fence(__ATOMIC_ACQUIRE, "agent");
    asm volatile("s_waitcnt vmcnt(0)" ::: "memory");
  }
  __syncthreads();
  const float* U = (const float*)(pws(p, OFF_U));
  const float* HF = (const float*)(pws(p, OFF_HF));
  const float* HB = (const float*)(pws(p, OFF_HB));
  const float* gm = pin(p, I_GML) + l * 256 + head * 64;
  const int i16 = tid & 15;
#pragma unroll 4
  for (int tt = tid >> 4; tt < 256; tt += 16) {
    const size_t tok = tok0 + tt;
    float4 a = *(const float4*)(HF + tok * 256 + head * 64 + i16 * 4);
    float4 b = *(const float4*)(HB + tok * 256 + head * 64 + i16 * 4);
    float h0 = a.x + b.x, h1 = a.y + b.y, h2 = a.z + b.z, h3 = a.w + b.w;
    float ss = h0 * h0 + h1 * h1 + h2 * h2 + h3 * h3;
    ss += shx<1>(ss); ss += shx<2>(ss); ss += shx<4>(ss); ss += shx<8>(ss);
    const float r = rsqrtf(ss * (1.0f / 64.0f) + EPS);
    float4 ov = *(const float4*)(U + tok * NIN + 768 + head * 64 + i16 * 4);
    float4 gg = *(const float4*)(gm + i16 * 4);
    float y0 = h0 * r * gg.x * sigmoidf_(ov.x);
    float y1 = h1 * r * gg.y * sigmoidf_(ov.y);
    float y2 = h2 * r * gg.z * sigmoidf_(ov.z);
    float y3 = h3 * r * gg.w * sigmoidf_(ov.w);
    *(uint2*)(YM + tok * DM + head * 64 + i16 * 4) = make_uint2(pack2(y0, y1), pack2(y2, y3));
  }
}

DI void phase_mixer(const Params& p, int lc, int kindmask, char* smem) {
  __shared__ int s_item;
  int* ctr = (int*)(pws(p, OFF_BAR)) + lc;
  const int l = lc & 1;
  bf16_t* YM = (bf16_t*)(pws(p, OFF_H));
  const bf16_t* QB = (const bf16_t*)(pws(p, OFF_QB));
  const bf16_t* QC = (const bf16_t*)(pws(p, OFF_QC));
  const bf16_t* KB = (const bf16_t*)(pws(p, OFF_KB));
  const bf16_t* VB = (const bf16_t*)(pws(p, OFF_VB));
  const bf16_t* KC = (const bf16_t*)(pws(p, OFF_KC));
  const bf16_t* VC = (const bf16_t*)(pws(p, OFF_VC));
  const int total = 32 + 128 + 256 + 128 + 128 + 128 + 128 + 1024 + 128;
  int* flags = (int*)(pws(p, OFF_BAR)) + FLAG_WORD0 + l * 80;
  while (true) {
    __syncthreads();
    if (otid() == 0) s_item = atomicAdd(ctr, 1);
    __syncthreads();
    int it = __builtin_amdgcn_readfirstlane(s_item);
    if (it >= total) break;
    int kind;
    bool lat = false, gl = false;
    int a0 = 0, a1 = 0, a2 = 0;
    if (it < 32) { kind = 0; lat = true; a0 = it >> 3; a1 = (it >> 1) & 3; a2 = it & 1; }
    else if ((it -= 32) < 128) { kind = 1; lat = true; gl = true; a0 = it >> 5; a1 = (it >> 3) & 3; a2 = it & 7; }
    else if ((it -= 128) < 256) { kind = 2; a0 = it >> 6; a1 = it & 63; }
    else if ((it -= 256) < 128) { kind = 1; lat = true; gl = false; a0 = it >> 5; a1 = (it >> 3) & 3; a2 = it & 7; }
    else if ((it -= 128) < 128) { kind = 0; lat = false; a0 = it >> 3; a1 = (it >> 1) & 3; a2 = it & 1; }
    else if ((it -= 128) < 128) { kind = 1; lat = false; gl = true; a0 = it >> 3; a1 = (it >> 1) & 3; a2 = it & 1; }
    else if ((it -= 128) < 128) { kind = 1; lat = false; gl = false; a0 = it >> 3; a1 = (it >> 1) & 3; a2 = it & 1; }
    else if ((it -= 128) < 1024) { kind = 3; a0 = it >> 6; a1 = it & 63; }
    else { it -= 1024; kind = 4; }
    if (kind == 4) {
      int tok0c, headc, fidx;
      if (it < 64) { const int sq = it >> 4; headc = (it >> 2) & 3; tok0c = NCTX + sq * 1024 + (it & 3) * 256; fidx = sq * 4 + headc; }
      else { const int sq = (it - 64) >> 2; headc = (it - 64) & 3; tok0c = sq * 256; fidx = 16 + sq * 4 + headc; }
      mlstm_combine_item(p, l, tok0c, headc, flags + fidx, YM);
      continue;
    }
    if (!((kindmask >> kind) & 1)) continue;
    if (kind == 0) {
#ifndef SKIP_MLSTM
      mlstm_dir_item(p, l, lat, a0, lat ? NCTX + a0 * 1024 : a0 * 256, lat ? 1024 : 256, a1, a2,
                     flags + (lat ? a0 * 4 + a1 : 16 + a0 * 4 + a1), smem);
#endif
    } else if (kind == 1) {
      const int head = a1, qb = a2;
      const int tok0 = lat ? NCTX + a0 * 1024 : a0 * 256;
      const size_t kr = (size_t)(lat ? NCTX + a0 * 1280 : tok0) * 128 + (head >> 1) * 64;
      int n1, start2 = 0, n2 = 0;
      if (lat && gl) n1 = 20;
      else if (lat) {
        const int lo = 2 * qb - 2 < 0 ? 0 : 2 * qb - 2, hi = 2 * qb + 3 > 15 ? 15 : 2 * qb + 3;
        n1 = 4; start2 = 4 + lo; n2 = hi - lo + 1;
      } else n1 = 4;
      const float sink = gl ? 0.f : pin(p, I_SINK)[l * 4 + head];
      attn_item((gl ? QB : QC) + (size_t)tok0 * 256 + head * 64, (gl ? KB : KC) + kr, (gl ? VB : VC) + kr, qb * 128, n1,
                start2, n2, lat && !gl, !gl, sink, YM + (size_t)tok0 * DM + (gl ? 256 : 512) + head * 64, smem);
    } else if (kind == 2) {
#ifndef SKIP_HYENA
      hyena_item<4>(p, l, NCTX + a0 * 1024, a1, YM, smem);
#endif
    } else {
#ifndef SKIP_HYENA
      hyena_item<1>(p, l, a0 * 256, a1, YM, smem);
#endif
    }
  }
}

__global__ void __launch_bounds__(256, 2) trunk_megakernel(Params p) {
  extern __shared__ __attribute__((aligned(16))) char smem[];
  cg::grid_group grid = cg::this_grid();
  __shared__ uint4 xb_words;
  if (threadIdx.x == 0) xb_words = make_uint4(0u, 0u, 0u, 0u);
  __syncthreads();
  if (p.out == nullptr) grid.sync();
  XcdBarrier xb = xcd_barrier_post((unsigned*)(pws(p, OFF_BAR)), (volatile LAS unsigned*)&xb_words);

#pragma unroll 1
  for (int ph = 0; ph < 24; ++ph) {
    const bf16_t* WT = (const bf16_t*)(pws(p, OFF_WT));
    const bf16_t* H = (const bf16_t*)(pws(p, OFF_H));
    float* X = (float*)(pws(p, OFF_X));
    float* U = (float*)(pws(p, OFF_U));
    bf16_t* ACT = (bf16_t*)(pws(p, OFF_U));
    const float* MOD = (const float*)(pws(p, OFF_MOD));
    if (ph == 0) {
#pragma unroll 1
      for (int rep = 0; rep < REP_PRO; ++rep) phase_prologue(p, smem);
    } else if (ph == 23) {
      phase_final_norm(p);
    } else {
      const int l = (ph - 1) / 11, s = (ph - 1) % 11;
      const float* modl = MOD + (size_t)l * 5 * NMOD;
      if (s == 0 || s == 3 || s == 8) {
        const float* g = (s == 0 ? pin(p, I_GFF1) : s == 3 ? pin(p, I_GMIX) : pin(p, I_GFF2)) + l * DM;
        const int ps = (s == 0) ? 0 : (s == 3) ? 3 : 6;
#pragma unroll 1
        for (int rep = 0; rep < REP_SMALL; ++rep)
          phase_norm(p, l, l == 0 && s == 0, g, ps, ps + 1);
        if (s == 0 && l == 1) {
#pragma unroll 1
          for (int rep = 0; rep < REP_PRO; ++rep) convert_layer(p, 1, smem);
        }
      } else if (s == 1 || s == 9) {
        EpiArgs ea{ACT, nullptr, nullptr, nullptr, 0.f};
#ifndef REP_GEMM
#define REP_GEMM 1
#endif
#pragma unroll 1
        for (int rep = 0; rep < REP_GEMM; ++rep)
        {
          gemm_k64<EPI_GU>(H, DM, WT + (s == 1 ? WT_GU1 : WT_GU2), DM, NTOK, NGU, DM, ea, smem);
        }
      } else if (s == 2 || s == 7 || s == 10) {
        const bool first = (l == 0 && s == 2);
        EpiArgs ea{X, first ? pin(p, I_XP) : X, first ? pin(p, I_XS) : X + (size_t)NCTX * DM,
                   modl + (s == 2 ? 2 : s == 7 ? 5 : 8) * 1024, s == 7 ? 1.0f : 0.5f};
        const bf16_t* A = (s == 7) ? H : ACT;
        const int K = (s == 7) ? DM : DFF;
        const bf16_t* B = WT + (s == 2 ? WT_D1 : s == 7 ? WT_OUT : WT_D2);
        gemm_k64<EPI_RES>(A, K, B, K, NTOK, DM, K, ea, smem);
#if REP_RES > 1
        {
          xcd_barrier(xb);
          EpiArgs eb{X, X, X + (size_t)NCTX * DM, ea.modp, 0.0f};
          gemm_k64<EPI_RES>(A, K, B, K, NTOK, DM, K, eb, smem);
        }
#endif
      } else if (s == 4) {
        EpiArgs ea{U, nullptr, nullptr, nullptr, 0.f};
#pragma unroll 1
        for (int rep = 0; rep < REP_GEMM; ++rep)
          gemm_k64<EPI_U>(H, DM, WT + WT_IN, DM, NTOK, NIN, DM, ea, smem);
      } else if (s == 5) {
#ifndef REP_SMALL
#define REP_SMALL 1
#endif
#pragma unroll 1
        for (int rep = 0; rep < REP_SMALL; ++rep)
          phase_prep(p, l);
      } else {
#ifndef REP_MIXER
#define REP_MIXER 1
#endif
#pragma unroll 1
        for (int rep = 0; rep < REP_MIXER; ++rep)
          phase_mixer(p, l + 2 * rep, rep == 0 ? 15 : REP_MASK, smem);
      }
    }
    if (ph < 23) {
      xcd_barrier(xb);
#if REP_BAR > 1
      xcd_barrier(xb);
#endif
    }
  }
}

extern "C" void kernel_launch(void* const* d_in, const int* in_sizes, int n_in, void* d_out, int out_size, void* d_ws,
                              size_t ws_size, hipStream_t stream) {
  static int grid_blocks = 0;
  if (!grid_blocks) {
    int dev = 0, cus = 0, per_cu = 0;
    hipGetDevice(&dev);
    hipDeviceGetAttribute(&cus, hipDeviceAttributeMultiprocessorCount, dev);
    hipFuncSetAttribute((const void*)trunk_megakernel, hipFuncAttributeMaxDynamicSharedMemorySize, LDS_BYTES);
    hipOccupancyMaxActiveBlocksPerMultiprocessor(&per_cu, trunk_megakernel, 256, LDS_BYTES);
    if (per_cu > 2) per_cu = 2;
    if (per_cu < 1) per_cu = 1;
    grid_blocks = cus * per_cu;
  }
  Params p{};
  for (int i = 0; i < 40; ++i) p.in[i] = (const float*)d_in[i];
  p.out = (float*)d_out;
  p.ws = (char*)d_ws;
  hipMemsetAsync((char*)d_ws + OFF_BAR, 0, 16384, stream);
  void* args[] = {&p};
  hipError_t e = hipLaunchCooperativeKernel((void*)trunk_megakernel, dim3(grid_blocks), dim3(256), args, LDS_BYTES, stream);
  if (e != hipSuccess) fprintf(stderr, "cooperative launch failed: %s (grid %d)\n", hipGetErrorString(e), grid_blocks);
}

#ifdef PROBE_PHASES
__global__ void __launch_bounds__(256, 2) k_mod(Params p) { extern __shared__ __attribute__((aligned(16))) char smem[]; mod_item(p, blockIdx.x, smem); }
__global__ void __launch_bounds__(256, 2) k_filt(Params p) { extern __shared__ __attribute__((aligned(16))) char smem[]; filt_item(p, blockIdx.x, smem); }
__global__ void __launch_bounds__(256, 2) k_conv(Params p) { extern __shared__ __attribute__((aligned(16))) char smem[]; convert_layer(p, 0, smem); }
__global__ void __launch_bounds__(256, 2) k_pro(Params p) { extern __shared__ __attribute__((aligned(16))) char smem[]; phase_prologue(p, smem); }
__global__ void __launch_bounds__(256, 2) k_norm(Params p) { phase_norm(p, 0, true, p.in[I_GFF1], 0, 1); }
__global__ void __launch_bounds__(256, 2) k_gemm_gu(Params p) { extern __shared__ __attribute__((aligned(16))) char smem[]; EpiArgs ea{p.ws, nullptr, nullptr, nullptr, 0.f}; gemm_phase<EPI_GU>((bf16_t*)p.ws, DM, (bf16_t*)p.ws, DM, NTOK, NGU, DM, ea, smem); }
__global__ void __launch_bounds__(256, 2) k_gemm_res(Params p) { extern __shared__ __attribute__((aligned(16))) char smem[]; EpiArgs ea{p.ws, p.in[0], p.in[1], p.in[2], 0.5f}; gemm_phase<EPI_RES>((bf16_t*)p.ws, DM, (bf16_t*)p.ws, DM, NTOK, DM, DM, ea, smem); }
__global__ void __launch_bounds__(256, 2) k_gemm_u(Params p) { extern __shared__ __attribute__((aligned(16))) char smem[]; EpiArgs ea{p.ws, nullptr, nullptr, nullptr, 0.f}; gemm_phase<EPI_U>((bf16_t*)p.ws, DM, (bf16_t*)p.ws, DM, NTOK, NIN, DM, ea, smem); }
__global__ void __launch_bounds__(256, 2) k_prep(Params p) { phase_prep(p, 0); }
__global__ void __launch_bounds__(256, 2) k_attn(Params p, int a, int b, int c, int d, bool w, bool hs, float sk) { extern __shared__ __attribute__((aligned(16))) char smem[]; attn_item((bf16_t*)p.ws, (bf16_t*)p.ws, (bf16_t*)p.ws, a, b, c, d, w, hs, sk, (bf16_t*)p.ws, smem); }
__global__ void __launch_bounds__(256, 2) k_hy4(Params p) { extern __shared__ __attribute__((aligned(16))) char smem[]; hyena_item<4>(p, 0, 0, blockIdx.x, (bf16_t*)p.ws, smem); }
__global__ void __launch_bounds__(256, 2) k_hy1(Params p) { extern __shared__ __attribute__((aligned(16))) char smem[]; hyena_item<1>(p, 0, 0, blockIdx.x, (bf16_t*)p.ws, smem); }
__global__ void __launch_bounds__(256, 2) k_mixer(Params p) { extern __shared__ __attribute__((aligned(16))) char smem[]; phase_mixer(p, 0, 15, smem); }
#endif
```

```cpp
#include <hip/hip_runtime.h>
#include <hip/hip_cooperative_groups.h>
#include <cstdio>
namespace cg = cooperative_groups;

#define DI __device__ __forceinline__
typedef unsigned short bf16_t;
using bf16x8 = __attribute__((ext_vector_type(8))) short;
using bf16x4 = __attribute__((ext_vector_type(4))) short;
using f32x4 = __attribute__((ext_vector_type(4))) float;

constexpr int NTOK = 8192, NCTX = 4096, DM = 1024, DFF = 2816, NIN = 2832, NGU = 5632;
constexpr int NMOD = 9216;
constexpr float EPS = 1e-6f;

enum { I_XP = 0, I_XS, I_SC, I_SN, I_SM, I_CGK, I_CGV, I_CSK, I_CSV, I_C, I_CCTX, I_WADA, I_BADA, I_GFF1,
       I_W1G, I_W1U, I_W1D, I_GMIX, I_WIN, I_BG, I_GML, I_GQN, I_GKN, I_SINK, I_CW, I_CB, I_FW1, I_FB1,
       I_FW2, I_FB2, I_FW3, I_FB3, I_FFR, I_HBIAS, I_WOUT, I_GFF2, I_W2G, I_W2U, I_W2D, I_GFIN };

constexpr size_t O_Y = 0, O_NC = 8388608, O_NN = 9437184, O_NM = 9453568, O_GK = 9453824, O_GV = 10502400,
                 O_SK = 11550976, O_SV = 12599552;

constexpr size_t MiB = 1u << 20;
constexpr size_t OFF_WT = 0, OFF_X = 44 * MiB, OFF_H = 76 * MiB, OFF_U = 92 * MiB, OFF_QB = 181 * MiB,
                 OFF_QC = 185 * MiB, OFF_KB = 189 * MiB, OFF_VB = 192 * MiB, OFF_KC = 195 * MiB, OFF_VC = 198 * MiB,
                 OFF_HF = 201 * MiB, OFF_HB = 209 * MiB, OFF_MOD = 217 * MiB, OFF_FILT = 218 * MiB,
                 OFF_ROPE = 221 * MiB, OFF_CTR = 222 * MiB, OFF_BAR = 223 * MiB;
constexpr size_t WT_GU1 = 0, WT_D1 = 5767168, WT_IN = 8650752, WT_OUT = 11550720, WT_GU2 = 12599296, WT_D2 = 18366464;

#ifndef REP_GEMM
#define REP_GEMM 1
#endif
#ifndef REP_MIXER
#define REP_MIXER 1
#endif
#ifndef REP_SMALL
#define REP_SMALL 1
#endif
#ifndef REP_PRO
#define REP_PRO 1
#endif
#define REP_RES 1
#define REP_MASK 15
#define REP_BAR 1
constexpr int LDS_BYTES = 79 * 1024;

struct Params {
  const float* in[40];
  float* out;
  char* ws;
};

DI const float* pin(const Params& p, int i) {
  asm volatile("" : "+s"(i));
  return p.in[i];
}
DI char* pws(const Params& p, size_t off) {
  asm volatile("" : "+s"(off));
  return p.ws + off;
}
DI float* pout(const Params& p) {
  int z = 0;
  asm volatile("" : "+s"(z));
  return p.out + z;
}
DI int otid() {
  int t = threadIdx.x;
  asm volatile("" : "+v"(t));
  return t;
}
DI int obid() {
  int b = blockIdx.x;
  asm volatile("" : "+s"(b));
  return b;
}
DI bf16_t f2bf(float x) {
  unsigned u = __float_as_uint(x);
  u += 0x7fffu + ((u >> 16) & 1u);
  return (bf16_t)(u >> 16);
}
DI float bf2f(bf16_t h) { return __uint_as_float(((unsigned)h) << 16); }
DI unsigned pack2(float a, float b) { return (unsigned)f2bf(a) | ((unsigned)f2bf(b) << 16); }
template <int K>
DI float shx(float v) {
  if constexpr (K < 32) return __int_as_float(__builtin_amdgcn_ds_swizzle(__float_as_int(v), (K << 10) | 0x1f));
  else return __shfl_xor(v, K);
}
DI float wave_sum(float v) {
  v += shx<32>(v); v += shx<16>(v); v += shx<8>(v); v += shx<4>(v); v += shx<2>(v); v += shx<1>(v);
  return v;
}
DI float sigmoidf_(float x) { return 1.f / (1.f + __expf(-x)); }
DI int mod_index(int row) { return row < NCTX ? 0 : 1 + ((row - NCTX) >> 10); }
#define MFMA16(a, b, c) __builtin_amdgcn_mfma_f32_16x16x32_bf16((a), (b), (c), 0, 0, 0)


#define XB_TMO      128
#define XB_XCNT(j)  (256  + 64 * (j))
#define XB_XSUB(j)  (1280 + 64 * (j))
#define XB_XGEN(j)  (2304 + 64 * (j))
#define XB_TOP      3328
#define XB_TOPGEN   3392
#define XCD_BAR_WORDS 3456
#define XB_SPIN_CAP (1u << 20)
#define LAS __attribute__((address_space(3)))
DI unsigned xb_ld(unsigned* p) { return __hip_atomic_load(p, __ATOMIC_RELAXED, __HIP_MEMORY_SCOPE_AGENT); }
DI unsigned xb_add(unsigned* p, unsigned v) { return __hip_atomic_fetch_add(p, v, __ATOMIC_RELAXED, __HIP_MEMORY_SCOPE_AGENT); }
DI unsigned xb_xcc_id() { return (unsigned)__builtin_amdgcn_s_getreg((3 << 11) | 20) & 0xFu; }
#define XB_SPIN(cond, bar) do { unsigned _sp = 0; while (cond) { __builtin_amdgcn_s_sleep(1); \
    if ((++_sp & 255u) == 0u) { if (xb_ld(&(bar)[XB_TMO])) break; if (_sp > XB_SPIN_CAP) { atomicAdd(&(bar)[XB_TMO], 1u); break; } } } } while (0)
struct XcdBarrier {
  unsigned* bar; unsigned x;
  volatile LAS unsigned* st;
};
DI XcdBarrier xcd_barrier_post(unsigned* bar, volatile LAS unsigned* st) {
  XcdBarrier b; b.bar = bar; b.x = xb_xcc_id(); b.st = st;
  if (threadIdx.x == 0) (void)xb_add(&bar[XB_XCNT(b.x)], 1u);
  return b;
}
DI void xcd_barrier_complete(unsigned* bar, unsigned x, unsigned& nloc, unsigned& nx) {
  const unsigned G = gridDim.x * gridDim.y * gridDim.z;
  unsigned sum, cnt, mine, sp = 0u;
  for (;;) {
    sum = 0u; cnt = 0u; mine = 0u;
#pragma unroll 1
    for (unsigned j = 0; j < 16; ++j) { const unsigned c = xb_ld(&bar[XB_XCNT(j)]); sum += c; cnt += (c > 0u) ? 1u : 0u; mine = (j == x) ? c : mine; }
    if (sum == G) break;
    __builtin_amdgcn_s_sleep(1);
    if ((++sp & 255u) == 0u) { if (xb_ld(&bar[XB_TMO])) break; if (sp > XB_SPIN_CAP) { atomicAdd(&bar[XB_TMO], 1u); break; } }
  }
  nloc = mine > 0u ? mine : 1u; nx = cnt > 0u ? cnt : 1u;
}
DI void xcd_barrier(const XcdBarrier& b) {
  asm volatile("s_waitcnt vmcnt(0)" ::: "memory");
  __syncthreads();
  if (threadIdx.x == 0) {
    unsigned* bar = b.bar;
    __builtin_amdgcn_s_waitcnt(0);
    unsigned nloc = b.st[0], nx = b.st[1];
    if (nloc == 0u) { xcd_barrier_complete(bar, b.x, nloc, nx); b.st[0] = nloc; b.st[1] = nx; }
    const unsigned old = xb_add(&bar[XB_XSUB(b.x)], 1u);
    const unsigned gen = old / nloc;
    if (old + 1u == (gen + 1u) * nloc) {
      __builtin_amdgcn_fence(__ATOMIC_RELEASE, "agent");
      asm volatile("s_waitcnt vmcnt(0)" ::: "memory");
      const unsigned og = xb_add(&bar[XB_TOP], 1u);
      const unsigned tg = og / nx;
      if (og + 1u == (tg + 1u) * nx) xb_add(&bar[XB_TOPGEN], 1u);
      else XB_SPIN(xb_ld(&bar[XB_TOPGEN]) == tg, bar);
      __builtin_amdgcn_fence(__ATOMIC_ACQUIRE, "agent");
      xb_add(&bar[XB_XGEN(b.x)], 1u);
      asm volatile("s_waitcnt vmcnt(0)" ::: "memory");
    } else {
      XB_SPIN(xb_ld(&bar[XB_XGEN(b.x)]) == gen, bar);
      __builtin_amdgcn_fence(__ATOMIC_ACQUIRE, "agent");
      asm volatile("s_waitcnt vmcnt(0)" ::: "memory");
    }
  }
  __syncthreads();
}

DI void mod_item(const Params& p, int it, char* smem) {
  const int tid = otid();
  float* sv = (float*)smem;
  float* red = sv + 5 * 1024;
  const int l = it / 144, j0 = (it % 144) * 64;
  __syncthreads();
  for (int i = tid; i < 5120; i += 256) {
    int v = i >> 10, k = i & 1023;
    float c = (v == 0) ? pin(p, I_CCTX)[k] : pin(p, I_C)[(v - 1) * 1024 + k];
    sv[i] = c / (1.f + expf(-c));
  }
  __syncthreads();
  const int c4 = tid & 15, kg = tid >> 4;
  float acc[5][4];
#pragma unroll
  for (int v = 0; v < 5; ++v)
#pragma unroll
    for (int i = 0; i < 4; ++i) acc[v][i] = 0.f;
  const float* w = pin(p, I_WADA) + (size_t)l * 1024 * NMOD + j0 + c4 * 4;
#pragma unroll 1
  for (int k0 = kg; k0 < 1024; k0 += 128) {
    float4 wv[8];
#pragma unroll
    for (int u = 0; u < 8; ++u) wv[u] = *(const float4*)(w + (size_t)(k0 + 16 * u) * NMOD);
#pragma unroll
    for (int u = 0; u < 8; ++u)
#pragma unroll
      for (int v = 0; v < 5; ++v) {
        float s = sv[v * 1024 + k0 + 16 * u];
        acc[v][0] += s * wv[u].x; acc[v][1] += s * wv[u].y; acc[v][2] += s * wv[u].z; acc[v][3] += s * wv[u].w;
      }
  }
#pragma unroll
  for (int v = 0; v < 5; ++v)
#pragma unroll
    for (int i = 0; i < 4; ++i) red[(kg * 5 + v) * 64 + c4 * 4 + i] = acc[v][i];
  __syncthreads();
  for (int o = tid; o < 320; o += 256) {
    int v = o >> 6, c = o & 63;
    float s = 0.f;
    for (int k = 0; k < 16; ++k) s += red[(k * 5 + v) * 64 + c];
    s += pin(p, I_BADA)[l * NMOD + j0 + c];
    ((float*)(pws(p, OFF_MOD)))[(size_t)(l * 5 + v) * NMOD + j0 + c] = s;
  }
}

DI void filt_item(const Params& p, int it, char* smem) {
  const int tid = otid(), q = tid >> 6, tl = tid & 63;
  float* w1s = (float*)smem;
  float* w2s = w1s + 33 * 64;
  float* feats = w2s + 64 * 64;
  float* z1 = feats + 8 * 36;
  float* z2 = z1 + 8 * 64;
  const int l = it / 160, rem = it % 160;
  const float* w1 = pin(p, I_FW1) + l * 33 * 64;
  const float* b1 = pin(p, I_FB1) + l * 64;
  const float* w2 = pin(p, I_FW2) + l * 64 * 64;
  const float* b2 = pin(p, I_FB2) + l * 64;
  const float* w3 = pin(p, I_FW3) + l * 64 * 256;
  const float* b3 = pin(p, I_FB3) + l * 256;
  const float frq = pin(p, I_FFR)[l * 64 + tl];
  float* filt = (float*)(pws(p, OFF_FILT)) + (size_t)l * 1280 * 256;
  __syncthreads();
  for (int i = tid; i < 33 * 64; i += 256) w1s[i] = w1[i];
  for (int i = tid; i < 64 * 64; i += 256) w2s[i] = w2[i];
  int pidx[2], Lp[2], pos[2];
#pragma unroll
  for (int u = 0; u < 2; ++u) {
    pidx[u] = rem * 8 + q + 4 * u;
    Lp[u] = pidx[u] < 256 ? 256 : 1024;
    pos[u] = pidx[u] < 256 ? pidx[u] : pidx[u] - 256;
    if (tl < 33) {
      float f;
      if (tl == 0) f = (float)pos[u] / (float)(Lp[u] - 1);
      else {
        int j = (tl - 1) & 15;
        float fj = 1e-4f + (float)j * ((15.0f - 1e-4f) / 15.0f);
        float ang = (6.283185307179586f / (float)Lp[u]) * (float)pos[u] * fj;
        f = (tl <= 16) ? cosf(ang) : -sinf(ang);
      }
      feats[(q + 4 * u) * 36 + tl] = f;
    }
  }
  __syncthreads();
  {
    float s0 = b1[tl], s1 = s0;
#pragma unroll 3
    for (int j = 0; j < 33; ++j) {
      float w = w1s[j * 64 + tl];
      s0 += feats[q * 36 + j] * w;
      s1 += feats[(q + 4) * 36 + j] * w;
    }
    z1[q * 64 + tl] = sinf(frq * s0);
    z1[(q + 4) * 64 + tl] = sinf(frq * s1);
  }
  __syncthreads();
  {
    float s0 = b2[tl], s1 = s0;
#pragma unroll 4
    for (int j = 0; j < 64; ++j) {
      float w = w2s[j * 64 + tl];
      s0 += z1[q * 64 + j] * w;
      s1 += z1[(q + 4) * 64 + j] * w;
    }
    z2[q * 64 + tl] = sinf(frq * s0);
    z2[(q + 4) * 64 + tl] = sinf(frq * s1);
  }
  __syncthreads();
  float dist[2];
#pragma unroll
  for (int u = 0; u < 2; ++u) {
    const int centre = Lp[u] / 2;
    dist[u] = fabsf((float)(pos[u] - centre)) / (float)centre;
  }
#pragma unroll 1
  for (int cc = 0; cc < 4; ++cc) {
    const int c = tl + 64 * cc;
    float s0 = b3[c], s1 = s0;
#pragma unroll 1
    for (int j0 = 0; j0 < 64; j0 += 16) {
      float w[16];
#pragma unroll
      for (int j = 0; j < 16; ++j) w[j] = w3[(j0 + j) * 256 + c];
#pragma unroll
      for (int j = 0; j < 16; ++j) {
        s0 += z2[q * 64 + j0 + j] * w[j];
        s1 += z2[(q + 4) * 64 + j0 + j] * w[j];
      }
    }
    const float a = -3.0701134573253944f, b = -15.350567286626972f;
    const float delta = fabsf(a + (float)c * ((b - a) / 255.0f));
    filt[(size_t)pidx[0] * 256 + c] = s0 * expf(-dist[0] * delta);
    filt[(size_t)pidx[1] * 256 + c] = s1 * expf(-dist[1] * delta);
  }
}

struct ConvT {
  const float* src;
  bf16_t* dst;
  int K, N, k0, n0, gu;
};
DI ConvT conv_decode(const Params& p, int l, int idx) {
  bf16_t* wt = (bf16_t*)(pws(p, OFF_WT));
  int t = idx, which, K, N, nNt, gu;
  size_t dsto;
  if (t < 704) { which = I_W1G; K = DM; N = DFF; nNt = 44; dsto = WT_GU1; gu = 1; }
  else if ((t -= 704) < 704) { which = I_W1U; K = DM; N = DFF; nNt = 44; dsto = WT_GU1; gu = 2; }
  else if ((t -= 704) < 704) { which = I_W1D; K = DFF; N = DM; nNt = 16; dsto = WT_D1; gu = 0; }
  else if ((t -= 704) < 720) { which = I_WIN; K = DM; N = NIN; nNt = 45; dsto = WT_IN; gu = 0; }
  else if ((t -= 720) < 256) { which = I_WOUT; K = DM; N = DM; nNt = 16; dsto = WT_OUT; gu = 0; }
  else if ((t -= 256) < 704) { which = I_W2G; K = DM; N = DFF; nNt = 44; dsto = WT_GU2; gu = 1; }
  else if ((t -= 704) < 704) { which = I_W2U; K = DM; N = DFF; nNt = 44; dsto = WT_GU2; gu = 2; }
  else { t -= 704; which = I_W2D; K = DFF; N = DM; nNt = 16; dsto = WT_D2; gu = 0; }
  ConvT c;
  c.src = pin(p, which) + (size_t)l * K * N;
  c.dst = wt + dsto;
  c.K = K; c.N = N; c.k0 = (t / nNt) * 64; c.n0 = (t % nNt) * 64; c.gu = gu;
  return c;
}
DI void conv_load(const ConvT& c, int tid, float4 v[4]) {
#pragma unroll
  for (int i = 0; i < 4; ++i) {
    int r = (tid >> 4) + 16 * i, c4 = (tid & 15) * 4;
    v[i] = make_float4(0.f, 0.f, 0.f, 0.f);
    if (c.n0 + c4 < c.N) v[i] = *(const float4*)(c.src + (size_t)(c.k0 + r) * c.N + c.n0 + c4);
  }
}
DI void convert_layer(const Params& p, int l, char* smem) {
  const int tid = otid();
  float* tile = (float*)smem;
  int idx = obid();
  if (idx >= 5200) return;
  ConvT cur = conv_decode(p, l, idx);
  float4 v[4];
  conv_load(cur, tid, v);
  while (true) {
    __syncthreads();
#pragma unroll
    for (int i = 0; i < 4; ++i) {
      int r = (tid >> 4) + 16 * i, c4 = (tid & 15) * 4;
      tile[r * 65 + c4 + 0] = v[i].x; tile[r * 65 + c4 + 1] = v[i].y; tile[r * 65 + c4 + 2] = v[i].z; tile[r * 65 + c4 + 3] = v[i].w;
    }
    const int nxt = idx + gridDim.x;
    ConvT nx = cur;
    if (nxt < 5200) {
      nx = conv_decode(p, l, nxt);
      conv_load(nx, tid, v);
    }
    __syncthreads();
    const int n = tid >> 2, kq = tid & 3;
    if (cur.n0 + n < cur.N) {
      int nn = cur.n0 + n;
      int drow = (cur.gu == 0) ? nn : ((nn >> 5) * 64 + (cur.gu - 1) * 32 + (nn & 31));
      unsigned pk[8];
#pragma unroll
      for (int i = 0; i < 8; ++i)
        pk[i] = pack2(tile[(kq * 16 + 2 * i) * 65 + n], tile[(kq * 16 + 2 * i + 1) * 65 + n]);
      uint4* d = (uint4*)(cur.dst + (size_t)drow * cur.K + cur.k0 + kq * 16);
      d[0] = make_uint4(pk[0], pk[1], pk[2], pk[3]);
      d[1] = make_uint4(pk[4], pk[5], pk[6], pk[7]);
    }
    if (nxt >= 5200) break;
    idx = nxt;
    cur = nx;
  }
}

DI void phase_prologue(const Params& p, char* smem) {
  const int nb = gridDim.x, b = obid(), tid = otid();
  for (int it = b; it < 288; it += nb) mod_item(p, it, smem);
  for (int it = nb - 1 - b; it < 320; it += nb) filt_item(p, it, smem);
  {
    float* cosT = (float*)(pws(p, OFF_ROPE));
    float* sinT = cosT + 32768;
    for (int i = b * 256 + tid; i < 32768; i += nb * 256) {
      int t = i >> 5, e = i & 31;
      float pos = (e < 16) ? (float)(t >> 6) : (float)(t & 63);
      float inv = powf(10000.0f, -(float)(e & 15) / 16.0f);
      float ang = pos * inv;
      cosT[i] = cosf(ang);
      sinT[i] = sinf(ang);
    }
  }
  convert_layer(p, 0, smem);
}

DI void phase_norm(const Params& p, int l, bool from_input, const float* g, int part_shift, int part_scale) {
  const int lane = otid() & 63, wid = otid() >> 6;
  const float* modl = (const float*)(pws(p, OFF_MOD)) + (size_t)l * 5 * NMOD;
  bf16_t* H = (bf16_t*)(pws(p, OFF_H));
  const float* X = (const float*)(pws(p, OFF_X));
  for (int row = obid() * 4 + wid; row < NTOK; row += gridDim.x * 4) {
    const float* xr = from_input ? (row < NCTX ? pin(p, I_XP) + (size_t)row * DM : pin(p, I_XS) + (size_t)(row - NCTX) * DM)
                                 : X + (size_t)row * DM;
    float4 v[4];
    float ss = 0.f;
#pragma unroll
    for (int i = 0; i < 4; ++i) {
      v[i] = ((const float4*)xr)[lane + 64 * i];
      ss += v[i].x * v[i].x + v[i].y * v[i].y + v[i].z * v[i].z + v[i].w * v[i].w;
    }
    ss = wave_sum(ss);
    const float r = rsqrtf(ss * (1.0f / DM) + EPS);
    const float* mrow = modl + (size_t)mod_index(row) * NMOD;
#pragma unroll
    for (int i = 0; i < 4; ++i) {
      int c = 4 * (lane + 64 * i);
      float4 gg = *(const float4*)(g + c);
      float4 sc = *(const float4*)(mrow + part_scale * 1024 + c);
      float4 sh = *(const float4*)(mrow + part_shift * 1024 + c);
      float o0 = v[i].x * r * gg.x * (1.f + sc.x) + sh.x;
      float o1 = v[i].y * r * gg.y * (1.f + sc.y) + sh.y;
      float o2 = v[i].z * r * gg.z * (1.f + sc.z) + sh.z;
      float o3 = v[i].w * r * gg.w * (1.f + sc.w) + sh.w;
      *(uint2*)(H + (size_t)row * DM + c) = make_uint2(pack2(o0, o1), pack2(o2, o3));
    }
  }
}

DI void phase_final_norm(const Params& p) {
  const int lane = otid() & 63, wid = otid() >> 6;
  const float* X = (const float*)(pws(p, OFF_X));
  const float* g = pin(p, I_GFIN);
  for (int row = obid() * 4 + wid; row < NTOK; row += gridDim.x * 4) {
    const float* xr = X + (size_t)row * DM;
    float4 v[4];
    float ss = 0.f;
#pragma unroll
    for (int i = 0; i < 4; ++i) {
      v[i] = ((const float4*)xr)[lane + 64 * i];
      ss += v[i].x * v[i].x + v[i].y * v[i].y + v[i].z * v[i].z + v[i].w * v[i].w;
    }
    ss = wave_sum(ss);
    const float r = rsqrtf(ss * (1.0f / DM) + EPS);
#pragma unroll
    for (int i = 0; i < 4; ++i) {
      int c = 4 * (lane + 64 * i);
      float4 gg = *(const float4*)(g + c);
      float4 o = make_float4(v[i].x * r * gg.x, v[i].y * r * gg.y, v[i].z * r * gg.z, v[i].w * r * gg.w);
      *(float4*)(pout(p) + O_Y + (size_t)row * DM + c) = o;
    }
  }
}

enum { EPI_GU = 0, EPI_RES = 1, EPI_U = 2 };
struct EpiArgs {
  void* out;
  const float* xin0;
  const float* xin1;
  const float* modp;
  float coef;
};

using f32x16 = __attribute__((ext_vector_type(16))) float;
#define MFMA32(a, b, c) __builtin_amdgcn_mfma_f32_32x32x16_bf16((a), (b), (c), 0, 0, 0)

template <int EPI>
DI void gemm_phase(const bf16_t* __restrict__ A, int lda, const bf16_t* __restrict__ Bt, int ldb, int M, int N, int K,
                   const EpiArgs ea, char* smem, int tile_lo = 0, int tile_hi = 1 << 30) {
  const int tid = otid(), lane = tid & 63, r32 = lane & 31, h = lane >> 5;
  const int wid = __builtin_amdgcn_readfirstlane(tid >> 6);
  const int wn = wid & 1, kh = wid >> 1;
  const int nM = M / 128, nN = (N + 127) / 128, ntiles = (nM * nN < tile_hi) ? nM * nN : tile_hi, nk = K / 32;
  const int lrow = tid >> 2;
  const int lkc = ((tid & 3) ^ ((tid >> 4) & 3)) * 8;
  const int fsw = ((kh * 2 + h) ^ ((r32 >> 2) & 3)) * 16;
  const int aoff = r32 * 64 + fsw;
  const int aoffk = aoff + kh * 4096, aoffg = aoff + (1 - kh) * 4096;
  const int boff = 8192 + (wn * 64 + r32) * 64 + fsw;
#define GEMM_ISSUE(kt_)                                                                                              \
  do {                                                                                                               \
    char* st_ = smem + ((kt_) & 3) * 16384 + wid * 1024;                                                             \
    const unsigned ko_ = (unsigned)(kt_) * 64u;                                                                      \
    __builtin_amdgcn_global_load_lds((const unsigned*)((const char*)A + (ao0 + ko_)), (unsigned*)(st_), 16, 0, 0);   \
    __builtin_amdgcn_global_load_lds((const unsigned*)((const char*)A + (ao1 + ko_)), (unsigned*)(st_ + 4096), 16, 0, 0); \
    __builtin_amdgcn_global_load_lds((const unsigned*)((const char*)Bt + (bo0 + ko_)), (unsigned*)(st_ + 8192), 16, 0, 0); \
    __builtin_amdgcn_global_load_lds((const unsigned*)((const char*)Bt + (bo1 + ko_)), (unsigned*)(st_ + 12288), 16, 0, 0); \
  } while (0)
#define GEMM_ADDR(tile_)                                                                                             \
  do {                                                                                                               \
    m0 = ((tile_) % nM) * 128;                                                                                       \
    n0 = ((tile_) / nM) * 128;                                                                                       \
    ao0 = (unsigned)((m0 + lrow) * lda + lkc) * 2u;                                                                  \
    ao1 = ao0 + (unsigned)(64 * lda) * 2u;                                                                           \
    int br0_ = n0 + lrow, br1_ = n0 + lrow + 64;                                                                     \
    br0_ = br0_ < N ? br0_ : N - 1;                                                                                  \
    br1_ = br1_ < N ? br1_ : N - 1;                                                                                  \
    bo0 = (unsigned)(br0_ * ldb + lkc) * 2u;                                                                         \
    bo1 = (unsigned)(br1_ * ldb + lkc) * 2u;                                                                         \
  } while (0)
  int tile = tile_lo + obid();
  int m0 = 0, n0 = 0;
  unsigned ao0 = 0, ao1 = 0, bo0 = 0, bo1 = 0;
  if (tile < ntiles) {
    GEMM_ADDR(tile);
    GEMM_ISSUE(0);
    GEMM_ISSUE(1);
    GEMM_ISSUE(2);
  }
  while (tile < ntiles) {
    f32x16 acc[4][2];
#pragma unroll
    for (int i = 0; i < 4; ++i)
#pragma unroll
      for (int j = 0; j < 2; ++j)
#pragma unroll
        for (int r = 0; r < 16; ++r) acc[i][j][r] = 0.f;
    for (int kt = 0; kt < nk; ++kt) {
      if (kt + 2 < nk) asm volatile("s_waitcnt vmcnt(8)" ::: "memory");
      else if (kt + 1 < nk) asm volatile("s_waitcnt vmcnt(4)" ::: "memory");
      else asm volatile("s_waitcnt vmcnt(0)" ::: "memory");
      asm volatile("s_waitcnt lgkmcnt(0)" ::: "memory");
      __builtin_amdgcn_s_barrier();
      if (kt + 3 < nk) GEMM_ISSUE(kt + 3);
      const char* st = smem + (kt & 3) * 16384;
      bf16x8 af[4], bfr[2];
#pragma unroll
      for (int i = 0; i < 4; ++i) af[i] = *(const bf16x8*)(st + ((i < 2) ? aoffk : aoffg) + (i & 1) * 2048);
#pragma unroll
      for (int j = 0; j < 2; ++j) bfr[j] = *(const bf16x8*)(st + boff + j * 2048);
#pragma unroll
      for (int i = 0; i < 4; ++i)
#pragma unroll
        for (int j = 0; j < 2; ++j) acc[i][j] = MFMA32(af[i], bfr[j], acc[i][j]);
    }
    asm volatile("s_waitcnt lgkmcnt(0)" ::: "memory");
    __builtin_amdgcn_s_barrier();
    {
      float* mine = (float*)(smem + wid * 16384);
      const float* theirs = (const float*)(smem + (wid ^ 2) * 16384);
#pragma unroll
      for (int i = 0; i < 2; ++i)
#pragma unroll
        for (int j = 0; j < 2; ++j)
#pragma unroll
          for (int r = 0; r < 16; ++r) mine[((i * 2 + j) * 16 + r) * 64 + lane] = acc[2 + i][j][r];
      __syncthreads();
#pragma unroll
      for (int i = 0; i < 2; ++i)
#pragma unroll
        for (int j = 0; j < 2; ++j) {
#pragma unroll
          for (int r = 0; r < 16; ++r) acc[i][j][r] += theirs[((i * 2 + j) * 16 + r) * 64 + lane];
          asm volatile("" ::: "memory");
        }
      asm volatile("s_waitcnt lgkmcnt(0)" ::: "memory");
      __builtin_amdgcn_s_barrier();
    }
    const int em0 = m0, en0 = n0;
    tile += gridDim.x;
    if (tile < ntiles) {
      GEMM_ADDR(tile);
      GEMM_ISSUE(0);
      GEMM_ISSUE(1);
      GEMM_ISSUE(2);
    }
    const int rbase = em0 + 2 * kh * 32 + 4 * h;
    if (EPI == EPI_GU) {
      bf16_t* act = (bf16_t*)ea.out + (size_t)rbase * DFF + ((en0 + wn * 64) >> 1) + r32;
#pragma unroll
      for (int mi = 0; mi < 2; ++mi)
#pragma unroll
        for (int rq = 0; rq < 4; ++rq) {
#pragma unroll
          for (int rr = 0; rr < 4; ++rr) {
            const int r = rq * 4 + rr;
            const float gt = acc[mi][0][r], up = acc[mi][1][r];
            act[(size_t)(mi * 32 + rr + 8 * rq) * DFF] = f2bf(gt / (1.f + __expf(-gt)) * up);
          }
          asm volatile("" ::: "memory");
        }
    } else if (EPI == EPI_RES) {
      float* X = (float*)ea.out + (size_t)rbase * DM + en0 + wn * 64 + r32;
      const float* xr = (em0 < NCTX ? ea.xin0 + (size_t)rbase * DM : ea.xin1 + (size_t)(rbase - NCTX) * DM) + en0 + wn * 64 + r32;
      const float* mr = ea.modp + (size_t)mod_index(em0) * NMOD + en0 + wn * 64 + r32;
      const float g0 = ea.coef * mr[0], g1 = ea.coef * mr[32];
#pragma unroll
      for (int mi = 0; mi < 2; ++mi)
#pragma unroll
        for (int rq = 0; rq < 4; ++rq) {
#pragma unroll
          for (int rr = 0; rr < 4; ++rr) {
            const int r = rq * 4 + rr;
            const size_t ro = (size_t)(mi * 32 + rr + 8 * rq) * DM;
            const float x0 = xr[ro], x1 = xr[ro + 32];
            X[ro] = x0 + g0 * acc[mi][0][r];
            X[ro + 32] = x1 + g1 * acc[mi][1][r];
          }
          asm volatile("" ::: "memory");
        }
    } else {
      float* U = (float*)ea.out + (size_t)rbase * NIN + en0 + wn * 64 + r32;
      const bool ok0 = en0 + wn * 64 + r32 < N, ok1 = en0 + wn * 64 + 32 + r32 < N;
#pragma unroll
      for (int mi = 0; mi < 2; ++mi)
#pragma unroll
        for (int rq = 0; rq < 4; ++rq) {
#pragma unroll
          for (int rr = 0; rr < 4; ++rr) {
            const int r = rq * 4 + rr;
            const size_t ro = (size_t)(mi * 32 + rr + 8 * rq) * NIN;
            if (ok0) U[ro] = acc[mi][0][r];
            if (ok1) U[ro + 32] = acc[mi][1][r];
          }
          asm volatile("" ::: "memory");
        }
    }
    asm volatile("s_waitcnt vmcnt(0)" ::: "memory");
  }
#undef GEMM_ISSUE
#undef GEMM_ADDR
}

template <int EPI>
DI void gemm_k64(const bf16_t* __restrict__ A, int lda, const bf16_t* __restrict__ Bt, int ldb, int M, int N, int K,
                   const EpiArgs ea, char* smem, int tile_lo = 0, int tile_hi = 1 << 30) {
  const int tid = otid(), lane = tid & 63, r32 = lane & 31, h = lane >> 5;
  const int wid = __builtin_amdgcn_readfirstlane(tid >> 6);
  const int wn = wid & 1, kh = wid >> 1;
  const int nM = M / 128, nN = (N + 127) / 128, ntiles = (nM * nN < tile_hi) ? nM * nN : tile_hi, nk = K / 64;
  const int lrow = tid >> 3;
  const int lkc = ((tid & 7) ^ ((tid >> 4) & 7)) * 8;
  const int fsw0 = ((kh * 4 + h) ^ ((r32 >> 1) & 7)) * 16, fsw1 = ((kh * 4 + 2 + h) ^ ((r32 >> 1) & 7)) * 16;
  const int aoffk = r32 * 128 + kh * 8192, aoffg = r32 * 128 + (1 - kh) * 8192;
  const int boff = 16384 + (wn * 64 + r32) * 128;
#define GEMM_ISSUE(kt_)                                                                                              \
  do {                                                                                                               \
    char* st_ = smem + ((kt_) & 1) * 32768 + wid * 1024;                                                             \
    const unsigned ko_ = (unsigned)(kt_) * 128u;                                                                     \
    _Pragma("unroll") for (int i_ = 0; i_ < 4; ++i_)                                                                 \
      __builtin_amdgcn_global_load_lds((const unsigned*)((const char*)A + (ao0 + i_ * ao32 + ko_)),                  \
                                       (unsigned*)(st_ + i_ * 4096), 16, 0, 0);                                      \
    _Pragma("unroll") for (int i_ = 0; i_ < 4; ++i_)                                                                 \
      __builtin_amdgcn_global_load_lds((const unsigned*)((const char*)Bt + (bo[i_] + ko_)),                          \
                                       (unsigned*)(st_ + 16384 + i_ * 4096), 16, 0, 0);                              \
  } while (0)
#define GEMM_ADDR(tile_)                                                                                             \
  do {                                                                                                               \
    m0 = ((tile_) % nM) * 128;                                                                                       \
    n0 = ((tile_) / nM) * 128;                                                                                       \
    ao0 = (unsigned)((m0 + lrow) * lda + lkc) * 2u;                                                                  \
    _Pragma("unroll") for (int i_ = 0; i_ < 4; ++i_) {                                                               \
      int br_ = n0 + lrow + 32 * i_;                                                                                 \
      br_ = br_ < N ? br_ : N - 1;                                                                                   \
      bo[i_] = (unsigned)(br_ * ldb + lkc) * 2u;                                                                     \
    }                                                                                                                \
  } while (0)
  const unsigned ao32 = (unsigned)(32 * lda) * 2u;
  int tile = tile_lo + obid();
  int m0 = 0, n0 = 0;
  unsigned ao0 = 0, bo[4] = {0, 0, 0, 0};
  if (tile < ntiles) {
    GEMM_ADDR(tile);
    GEMM_ISSUE(0);
  }
  while (tile < ntiles) {
    f32x16 acc[4][2];
#pragma unroll
    for (int i = 0; i < 4; ++i)
#pragma unroll
      for (int j = 0; j < 2; ++j)
#pragma unroll
        for (int r = 0; r < 16; ++r) acc[i][j][r] = 0.f;
    for (int kt = 0; kt < nk; ++kt) {
      asm volatile("s_waitcnt vmcnt(0)" ::: "memory");
      asm volatile("s_waitcnt lgkmcnt(0)" ::: "memory");
      __builtin_amdgcn_s_barrier();
      if (kt + 1 < nk) GEMM_ISSUE(kt + 1);
      const char* st = smem + (kt & 1) * 32768;
#pragma unroll
      for (int ks = 0; ks < 2; ++ks) {
        const int fsw = ks ? fsw1 : fsw0;
        bf16x8 af[4], bfr[2];
#pragma unroll
        for (int i = 0; i < 4; ++i) af[i] = *(const bf16x8*)(st + ((i < 2) ? aoffk : aoffg) + (i & 1) * 4096 + fsw);
#pragma unroll
        for (int j = 0; j < 2; ++j) bfr[j] = *(const bf16x8*)(st + boff + j * 4096 + fsw);
#pragma unroll
        for (int i = 0; i < 4; ++i)
#pragma unroll
          for (int j = 0; j < 2; ++j) acc[i][j] = MFMA32(af[i], bfr[j], acc[i][j]);
      }
    }
    asm volatile("s_waitcnt lgkmcnt(0)" ::: "memory");
    __builtin_amdgcn_s_barrier();
    {
      float* mine = (float*)(smem + wid * 16384);
      const float* theirs = (const float*)(smem + (wid ^ 2) * 16384);
#pragma unroll
      for (int i = 0; i < 2; ++i)
#pragma unroll
        for (int j = 0; j < 2; ++j)
#pragma unroll
          for (int r = 0; r < 16; ++r) mine[((i * 2 + j) * 16 + r) * 64 + lane] = acc[2 + i][j][r];
      __syncthreads();
#pragma unroll
      for (int i = 0; i < 2; ++i)
#pragma unroll
        for (int j = 0; j < 2; ++j) {
#pragma unroll
          for (int r = 0; r < 16; ++r) acc[i][j][r] += theirs[((i * 2 + j) * 16 + r) * 64 + lane];
          asm volatile("" ::: "memory");
        }
      asm volatile("s_waitcnt lgkmcnt(0)" ::: "memory");
      __builtin_amdgcn_s_barrier();
    }
    const int em0 = m0, en0 = n0;
    tile += gridDim.x;
    if (tile < ntiles) {
      GEMM_ADDR(tile);
      GEMM_ISSUE(0);
    }
    const int rbase = em0 + 2 * kh * 32 + 4 * h;
    if (EPI == EPI_GU) {
      bf16_t* act = (bf16_t*)ea.out + (size_t)rbase * DFF + ((en0 + wn * 64) >> 1) + r32;
#pragma unroll
      for (int mi = 0; mi < 2; ++mi)
#pragma unroll
        for (int rq = 0; rq < 4; ++rq) {
#pragma unroll
          for (int rr = 0; rr < 4; ++rr) {
            const int r = rq * 4 + rr;
            const float gt = acc[mi][0][r], up = acc[mi][1][r];
            act[(size_t)(mi * 32 + rr + 8 * rq) * DFF] = f2bf(gt / (1.f + __expf(-gt)) * up);
          }
          asm volatile("" ::: "memory");
        }
    } else if (EPI == EPI_RES) {
      float* X = (float*)ea.out + (size_t)rbase * DM + en0 + wn * 64 + r32;
      const float* xr = (em0 < NCTX ? ea.xin0 + (size_t)rbase * DM : ea.xin1 + (size_t)(rbase - NCTX) * DM) + en0 + wn * 64 + r32;
      const float* mr = ea.modp + (size_t)mod_index(em0) * NMOD + en0 + wn * 64 + r32;
      const float g0 = ea.coef * mr[0], g1 = ea.coef * mr[32];
      float xv[2][16][2];
#pragma unroll
      for (int mi = 0; mi < 2; ++mi)
#pragma unroll
        for (int r = 0; r < 16; ++r) {
          const size_t ro = (size_t)(mi * 32 + (r & 3) + 8 * (r >> 2)) * DM;
          xv[mi][r][0] = xr[ro];
          xv[mi][r][1] = xr[ro + 32];
        }
#pragma unroll
      for (int mi = 0; mi < 2; ++mi)
#pragma unroll
        for (int r = 0; r < 16; ++r) {
          const size_t ro = (size_t)(mi * 32 + (r & 3) + 8 * (r >> 2)) * DM;
          X[ro] = xv[mi][r][0] + g0 * acc[mi][0][r];
          X[ro + 32] = xv[mi][r][1] + g1 * acc[mi][1][r];
        }
    } else {
      float* U = (float*)ea.out + (size_t)rbase * NIN + en0 + wn * 64 + r32;
      const bool ok0 = en0 + wn * 64 + r32 < N, ok1 = en0 + wn * 64 + 32 + r32 < N;
#pragma unroll
      for (int mi = 0; mi < 2; ++mi)
#pragma unroll
        for (int rq = 0; rq < 4; ++rq) {
#pragma unroll
          for (int rr = 0; rr < 4; ++rr) {
            const int r = rq * 4 + rr;
            const size_t ro = (size_t)(mi * 32 + rr + 8 * rq) * NIN;
            if (ok0) U[ro] = acc[mi][0][r];
            if (ok1) U[ro + 32] = acc[mi][1][r];
          }
          asm volatile("" ::: "memory");
        }
    }
    asm volatile("s_waitcnt vmcnt(0)" ::: "memory");
  }
#undef GEMM_ISSUE
#undef GEMM_ADDR
}

template <int EPI>
DI void gemm_big(const bf16_t* __restrict__ A, int lda, const bf16_t* __restrict__ Bt, int ldb, int M, int N, int K,
                 const EpiArgs ea, char* smem, int tile_hi = 1 << 30) {
  const int tid = otid(), lane = tid & 63, r32 = lane & 31, h = lane >> 5;
  const int wid = __builtin_amdgcn_readfirstlane(tid >> 6);
  const int wm = wid >> 1, wn = wid & 1;
  const int nM = M / 256, nN = N / 128, ntiles = (nM * nN < tile_hi) ? nM * nN : tile_hi, nk = K / 32;
  const int lrow = tid >> 2;
  const int lkc = ((tid & 3) ^ ((tid >> 4) & 3)) * 8;
  const int sw0 = ((0 + h) ^ ((r32 >> 2) & 3)) * 16, sw1 = ((2 + h) ^ ((r32 >> 2) & 3)) * 16;
  const int arow = (wm * 128 + r32) * 64;
  const int brow = 16384 + (wn * 64 + r32) * 64;
#define BIG_ISSUE(kt_, st_i)                                                                                         \
  do {                                                                                                               \
    char* st_ = smem + (st_i) * 24576 + wid * 1024;                                                                  \
    const unsigned ko_ = (unsigned)(kt_) * 64u;                                                                      \
    __builtin_amdgcn_global_load_lds((const unsigned*)((const char*)A + (ao0 + ko_)), (unsigned*)(st_), 16, 0, 0);   \
    __builtin_amdgcn_global_load_lds((const unsigned*)((const char*)A + (ao0 + ao64 + ko_)), (unsigned*)(st_ + 4096), 16, 0, 0); \
    __builtin_amdgcn_global_load_lds((const unsigned*)((const char*)A + (ao0 + 2 * ao64 + ko_)), (unsigned*)(st_ + 8192), 16, 0, 0); \
    __builtin_amdgcn_global_load_lds((const unsigned*)((const char*)A + (ao0 + 3 * ao64 + ko_)), (unsigned*)(st_ + 12288), 16, 0, 0); \
    __builtin_amdgcn_global_load_lds((const unsigned*)((const char*)Bt + (bo0 + ko_)), (unsigned*)(st_ + 16384), 16, 0, 0); \
    __builtin_amdgcn_global_load_lds((const unsigned*)((const char*)Bt + (bo0 + bo64 + ko_)), (unsigned*)(st_ + 20480), 16, 0, 0); \
  } while (0)
#define BIG_ADDR(tile_)                                                                                              \
  do {                                                                                                               \
    m0 = ((tile_) % nM) * 256;                                                                                       \
    n0 = ((tile_) / nM) * 128;                                                                                       \
    ao0 = (unsigned)((m0 + lrow) * lda + lkc) * 2u;                                                                  \
    bo0 = (unsigned)((n0 + lrow) * ldb + lkc) * 2u;                                                                  \
  } while (0)
  const unsigned ao64 = (unsigned)(64 * lda) * 2u, bo64 = (unsigned)(64 * ldb) * 2u;
  int tile = obid();
  int m0 = 0, n0 = 0;
  unsigned ao0 = 0, bo0 = 0;
  if (tile < ntiles) {
    BIG_ADDR(tile);
    BIG_ISSUE(0, 0);
    BIG_ISSUE(1, 1);
  }
  while (tile < ntiles) {
    f32x16 acc[4][2];
#pragma unroll
    for (int i = 0; i < 4; ++i)
#pragma unroll
      for (int j = 0; j < 2; ++j)
#pragma unroll
        for (int r = 0; r < 16; ++r) acc[i][j][r] = 0.f;
    int sc = 0;
    for (int kt = 0; kt < nk; ++kt) {
      if (kt + 1 < nk) asm volatile("s_waitcnt vmcnt(6)" ::: "memory");
      else asm volatile("s_waitcnt vmcnt(0)" ::: "memory");
      asm volatile("s_waitcnt lgkmcnt(0)" ::: "memory");
      __builtin_amdgcn_s_barrier();
      if (kt + 2 < nk) {
        const int sn = sc == 0 ? 2 : sc - 1;
        BIG_ISSUE(kt + 2, sn);
      }
      const char* st = smem + sc * 24576;
      {
        bf16x8 af[4], bfr[2];
#pragma unroll
        for (int i = 0; i < 4; ++i) af[i] = *(const bf16x8*)(st + arow + i * 2048 + sw0);
#pragma unroll
        for (int j = 0; j < 2; ++j) bfr[j] = *(const bf16x8*)(st + brow + j * 2048 + sw0);
#pragma unroll
        for (int i = 0; i < 4; ++i)
#pragma unroll
          for (int j = 0; j < 2; ++j) acc[i][j] = MFMA32(af[i], bfr[j], acc[i][j]);
      }
      {
        bf16x8 af[4], bfr[2];
#pragma unroll
        for (int i = 0; i < 4; ++i) af[i] = *(const bf16x8*)(st + arow + i * 2048 + sw1);
#pragma unroll
        for (int j = 0; j < 2; ++j) bfr[j] = *(const bf16x8*)(st + brow + j * 2048 + sw1);
#pragma unroll
        for (int i = 0; i < 4; ++i)
#pragma unroll
          for (int j = 0; j < 2; ++j) acc[i][j] = MFMA32(af[i], bfr[j], acc[i][j]);
      }
      sc = sc == 2 ? 0 : sc + 1;
    }
    asm volatile("s_waitcnt lgkmcnt(0)" ::: "memory");
    __builtin_amdgcn_s_barrier();
    const int em0 = m0, en0 = n0;
    tile += gridDim.x;
    if (tile < ntiles) {
      BIG_ADDR(tile);
      BIG_ISSUE(0, 0);
      BIG_ISSUE(1, 1);
    }
    const int rbase = em0 + wm * 128 + 4 * h;
    if (EPI == EPI_GU) {
      bf16_t* act = (bf16_t*)ea.out + (size_t)rbase * DFF + ((en0 + wn * 64) >> 1) + r32;
#pragma unroll
      for (int mt = 0; mt < 4; ++mt)
#pragma unroll
        for (int rq = 0; rq < 4; ++rq) {
#pragma unroll
          for (int rr = 0; rr < 4; ++rr) {
            const int r = rq * 4 + rr;
            const float gt = acc[mt][0][r], up = acc[mt][1][r];
            act[(size_t)(mt * 32 + rr + 8 * rq) * DFF] = f2bf(gt / (1.f + __expf(-gt)) * up);
          }
          asm volatile("" ::: "memory");
        }
    } else {
      float* X = (float*)ea.out + (size_t)rbase * DM + en0 + wn * 64 + r32;
      const float* xr = (em0 < NCTX ? ea.xin0 + (size_t)rbase * DM : ea.xin1 + (size_t)(rbase - NCTX) * DM) + en0 + wn * 64 + r32;
      const float* mr = ea.modp + (size_t)mod_index(em0) * NMOD + en0 + wn * 64 + r32;
      const float g0 = ea.coef * mr[0], g1 = ea.coef * mr[32];
#pragma unroll
      for (int mt = 0; mt < 4; ++mt)
#pragma unroll
        for (int rq = 0; rq < 4; ++rq) {
#pragma unroll
          for (int rr = 0; rr < 4; ++rr) {
            const int r = rq * 4 + rr;
            const size_t ro = (size_t)(mt * 32 + rr + 8 * rq) * DM;
            const float x0 = xr[ro], x1 = xr[ro + 32];
            X[ro] = x0 + g0 * acc[mt][0][r];
            X[ro + 32] = x1 + g1 * acc[mt][1][r];
          }
          asm volatile("" ::: "memory");
        }
    }
    asm volatile("s_waitcnt vmcnt(0)" ::: "memory");
  }
#undef BIG_ISSUE
#undef BIG_ADDR
}

DI int key_row(int t) { return t < NCTX ? t : NCTX + ((t - NCTX) >> 10) * 1280 + 256 + ((t - NCTX) & 1023); }

DI void phase_prep(const Params& p, int l) {
  const int tid = otid();
  const float* U = (const float*)(pws(p, OFF_U));
  bf16_t* QB = (bf16_t*)(pws(p, OFF_QB));
  bf16_t* QC = (bf16_t*)(pws(p, OFF_QC));
  bf16_t* KB = (bf16_t*)(pws(p, OFF_KB));
  bf16_t* VB = (bf16_t*)(pws(p, OFF_VB));
  bf16_t* KC = (bf16_t*)(pws(p, OFF_KC));
  bf16_t* VC = (bf16_t*)(pws(p, OFF_VC));
  const float* cosT = (const float*)(pws(p, OFF_ROPE));
  const float* sinT = cosT + 32768;
  const float* gq = pin(p, I_GQN) + l * 64;
  const float* gk = pin(p, I_GKN) + l * 64;
  const int gid = (obid() * 256 + tid) >> 4, ngroups = gridDim.x * 16, i16 = tid & 15;
  const int nunits = NTOK * 16;
  for (int base = 0; base < nunits; base += ngroups) {
    int unit = base + gid;
    const bool valid = unit < nunits;
    if (!valid) unit = nunits - 1;
    const int t = unit >> 4, hv = unit & 15;
    int col;
    if (hv < 4) col = 1040 + hv * 64;
    else if (hv < 6) col = 1296 + (hv - 4) * 64;
    else if (hv < 8) col = 1424 + (hv - 6) * 64;
    else if (hv < 12) col = 1552 + (hv - 8) * 64;
    else if (hv < 14) col = 1808 + (hv - 12) * 64;
    else col = 1936 + (hv - 14) * 64;
    float4 xv = *(const float4*)(U + (size_t)t * NIN + col + i16 * 4);
    float x[4] = {xv.x, xv.y, xv.z, xv.w};
    const bool lat = t >= NCTX;
    const bool do_norm = hv < 6;
    const bool is_q = (hv < 4) || (hv >= 8 && hv < 12);
    const bool is_v = (hv == 6 || hv == 7 || hv >= 14);
    float ss = x[0] * x[0] + x[1] * x[1] + x[2] * x[2] + x[3] * x[3];
    ss += shx<1>(ss); ss += shx<2>(ss); ss += shx<4>(ss); ss += shx<8>(ss);
    if (do_norm) {
      const float r = rsqrtf(ss * (1.0f / 64.0f) + EPS);
      const float* gg = (hv < 4) ? gq : gk;
#pragma unroll
      for (int j = 0; j < 4; ++j) x[j] = x[j] * r * gg[i16 * 4 + j];
    }
    if (!lat && valid && !is_q) {
      const int b = t >> 8, s = t & 255;
      size_t o;
      int kvh;
      if (hv < 6) { o = O_GK; kvh = hv - 4; }
      else if (hv < 8) { o = O_GV; kvh = hv - 6; }
      else if (hv < 14) { o = O_SK; kvh = hv - 12; }
      else { o = O_SV; kvh = hv - 14; }
      float* dst = pout(p) + o + ((size_t)((b * 2 + l) * 256 + s)) * 128 + kvh * 64 + i16 * 4;
      *(float4*)dst = make_float4(x[0], x[1], x[2], x[3]);
    }
    float xp[4];
#pragma unroll
    for (int j = 0; j < 4; ++j) xp[j] = shx<4>(x[j]);
    if (lat && !is_v) {
      const int s = (t - NCTX) & 1023;
      const bool first = (i16 & 4) == 0;
#pragma unroll
      for (int j = 0; j < 4; ++j) {
        int d = i16 * 4 + j;
        int e = (d < 32) ? (d & 15) : 16 + (d & 15);
        float cs = cosT[s * 32 + e], sn = sinT[s * 32 + e];
        x[j] = first ? (x[j] * cs - xp[j] * sn) : (x[j] * cs + xp[j] * sn);
      }
    }
    if (is_q) {
#pragma unroll
      for (int j = 0; j < 4; ++j) x[j] *= 0.125f;
    }
    if (valid) {
      uint2 pk = make_uint2(pack2(x[0], x[1]), pack2(x[2], x[3]));
      bf16_t* dst;
      if (hv < 4) dst = QB + (size_t)t * 256 + hv * 64;
      else if (hv < 6) dst = KB + (size_t)key_row(t) * 128 + (hv - 4) * 64;
      else if (hv < 8) dst = VB + (size_t)key_row(t) * 128 + (hv - 6) * 64;
      else if (hv < 12) dst = QC + (size_t)t * 256 + (hv - 8) * 64;
      else if (hv < 14) dst = KC + (size_t)key_row(t) * 128 + (hv - 12) * 64;
      else dst = VC + (size_t)key_row(t) * 128 + (hv - 14) * 64;
      *(uint2*)(dst + i16 * 4) = pk;
    }
  }
  for (int i = obid() * 256 + tid; i < 4 * 4 * 256 * 32; i += gridDim.x * 256) {
    const int which = i >> 15, rem = i & 32767;
    const int b = rem >> 13, s = (rem >> 5) & 255, c4 = (rem & 31) * 4;
    const float* srcb = (which == 0) ? pin(p, I_CGK) : (which == 1) ? pin(p, I_CGV) : (which == 2) ? pin(p, I_CSK) : pin(p, I_CSV);
    const float* src = srcb + ((size_t)((b * 2 + l) * 256 + s)) * 128 + c4;
    float4 v = *(const float4*)src;
    bf16_t* dstb = (which == 0) ? KB : (which == 1) ? VB : (which == 2) ? KC : VC;
    *(uint2*)(dstb + (size_t)(NCTX + b * 1280 + s) * 128 + c4) = make_uint2(pack2(v.x, v.y), pack2(v.z, v.w));
  }
}

DI void attn_item(const bf16_t* Q, const bf16_t* K, const bf16_t* V, int q0, int n1, int start2, int n2, bool window,
                  bool has_sink, float sink, bf16_t* Y, char* smem) {
  const int tid = otid(), lane = tid & 63, wid = tid >> 6, g = lane >> 4, r16 = lane & 15;
  bf16_t* Ks = (bf16_t*)smem;
  bf16_t* Vt = Ks + 64 * 72;
  int qrow[2];
  bf16x8 qf[2][2];
  float m_run[2], l_run[2];
  f32x4 o[2][4];
#pragma unroll
  for (int u = 0; u < 2; ++u) {
    qrow[u] = q0 + wid * 32 + u * 16 + r16;
    qf[u][0] = *(const bf16x8*)(Q + (size_t)qrow[u] * 256 + g * 8);
    qf[u][1] = *(const bf16x8*)(Q + (size_t)qrow[u] * 256 + 32 + g * 8);
    m_run[u] = has_sink ? sink : -INFINITY;
    l_run[u] = (has_sink && g == 0) ? 1.f : 0.f;
#pragma unroll
    for (int i = 0; i < 4; ++i) o[u][i] = (f32x4){0.f, 0.f, 0.f, 0.f};
  }
  const int ntl = n1 + n2;
  uint4 pk[2], pv[2];
#pragma unroll
  for (int j = 0; j < 2; ++j) {
    int c = tid + 256 * j, key = c >> 3, dc = (c & 7) * 8;
    const int tile0 = n1 > 0 ? 0 : start2;
    pk[j] = *(const uint4*)(K + (size_t)(tile0 * 64 + key) * 128 + dc);
    pv[j] = *(const uint4*)(V + (size_t)(tile0 * 64 + key) * 128 + dc);
  }
  for (int ti = 0; ti < ntl; ++ti) {
    const int tile = ti < n1 ? ti : start2 + (ti - n1);
    __syncthreads();
#pragma unroll
    for (int j = 0; j < 2; ++j) {
      int c = tid + 256 * j, key = c >> 3, dc = (c & 7) * 8;
      uint4 kv = pk[j];
      *(uint4*)(Ks + key * 72 + dc) = kv;
      uint4 vv = pv[j];
      unsigned w[4] = {vv.x, vv.y, vv.z, vv.w};
#pragma unroll
      for (int i = 0; i < 4; ++i) {
        Vt[(dc + 2 * i) * 72 + key] = (bf16_t)(w[i] & 0xffffu);
        Vt[(dc + 2 * i + 1) * 72 + key] = (bf16_t)(w[i] >> 16);
      }
    }
    __syncthreads();
    if (ti + 1 < ntl) {
      const int tnext = (ti + 1) < n1 ? (ti + 1) : start2 + (ti + 1 - n1);
#pragma unroll
      for (int j = 0; j < 2; ++j) {
        int c = tid + 256 * j, key = c >> 3, dc = (c & 7) * 8;
        pk[j] = *(const uint4*)(K + (size_t)(tnext * 64 + key) * 128 + dc);
        pv[j] = *(const uint4*)(V + (size_t)(tnext * 64 + key) * 128 + dc);
      }
    }
    f32x4 s[2][4];
#pragma unroll
    for (int kt = 0; kt < 4; ++kt) {
      bf16x8 a0 = *(const bf16x8*)(Ks + (kt * 16 + r16) * 72 + g * 8);
      bf16x8 a1 = *(const bf16x8*)(Ks + (kt * 16 + r16) * 72 + 32 + g * 8);
#pragma unroll
      for (int u = 0; u < 2; ++u) {
        f32x4 z = (f32x4){0.f, 0.f, 0.f, 0.f};
        z = MFMA16(a0, qf[u][0], z);
        s[u][kt] = MFMA16(a1, qf[u][1], z);
      }
    }
    bf16x8 pb[2][2];
#pragma unroll
    for (int u = 0; u < 2; ++u) {
      if (window && tile >= 4) {
#pragma unroll
        for (int kt = 0; kt < 4; ++kt)
#pragma unroll
          for (int j = 0; j < 4; ++j) {
            int kp = (tile - 4) * 64 + kt * 16 + g * 4 + j;
            int dlt = kp - qrow[u];
            if (dlt > 128 || dlt < -128) s[u][kt][j] = -INFINITY;
          }
      }
      float mx = -INFINITY;
#pragma unroll
      for (int kt = 0; kt < 4; ++kt)
#pragma unroll
        for (int j = 0; j < 4; ++j) mx = fmaxf(mx, s[u][kt][j]);
      mx = fmaxf(mx, shx<16>(mx));
      mx = fmaxf(mx, __shfl_xor(mx, 32));
      const float m_new = fmaxf(m_run[u], mx);
      float alpha, msub;
      if (m_new == -INFINITY) { alpha = 1.f; msub = 0.f; }
      else { alpha = __expf(m_run[u] - m_new); msub = m_new; }
      float lsum = 0.f;
#pragma unroll
      for (int kt = 0; kt < 4; ++kt)
#pragma unroll
        for (int j = 0; j < 4; ++j) {
          float pe = __expf(s[u][kt][j] - msub);
          s[u][kt][j] = pe;
          lsum += pe;
        }
      l_run[u] = l_run[u] * alpha + lsum;
      m_run[u] = m_new;
#pragma unroll
      for (int i = 0; i < 4; ++i) o[u][i] *= alpha;
#pragma unroll
      for (int c = 0; c < 2; ++c) {
        unsigned* pw = (unsigned*)&pb[u][c];
        pw[0] = pack2(s[u][2 * c][0], s[u][2 * c][1]);
        pw[1] = pack2(s[u][2 * c][2], s[u][2 * c][3]);
        pw[2] = pack2(s[u][2 * c + 1][0], s[u][2 * c + 1][1]);
        pw[3] = pack2(s[u][2 * c + 1][2], s[u][2 * c + 1][3]);
      }
    }
#pragma unroll
    for (int c = 0; c < 2; ++c)
#pragma unroll
      for (int et = 0; et < 4; ++et) {
        const bf16_t* vp = Vt + (et * 16 + r16) * 72 + c * 32 + g * 4;
        bf16x4 lo = *(const bf16x4*)(vp);
        bf16x4 hi = *(const bf16x4*)(vp + 16);
        bf16x8 a = __builtin_shufflevector(lo, hi, 0, 1, 2, 3, 4, 5, 6, 7);
#pragma unroll
        for (int u = 0; u < 2; ++u) o[u][et] = MFMA16(a, pb[u][c], o[u][et]);
      }
  }
#pragma unroll
  for (int u = 0; u < 2; ++u) {
    float lt = l_run[u];
    lt += shx<16>(lt);
    lt += __shfl_xor(lt, 32);
    const float inv = 1.f / lt;
#pragma unroll
    for (int et = 0; et < 4; ++et) {
      uint2 pk2 = make_uint2(pack2(o[u][et][0] * inv, o[u][et][1] * inv), pack2(o[u][et][2] * inv, o[u][et][3] * inv));
      *(uint2*)(Y + (size_t)qrow[u] * DM + et * 16 + g * 4) = pk2;
    }
  }
}

using f32x2 = __attribute__((ext_vector_type(2))) float;
template <int NI>
DI void hyena_item(const Params& p, int l, int tok0, int cq, bf16_t* YM, char* smem) {
  constexpr int L = NI * 256;
  constexpr int NH = (NI >= 2) ? NI / 2 : 1;
  const int tid = otid(), lane = tid & 63;
  const int wid = __builtin_amdgcn_readfirstlane(tid >> 6);
  const int pr = wid & 1, hf = wid >> 1;
  const int c0 = cq * 4, ca = c0 + 2 * pr;
  f32x2* zz = (f32x2*)((float*)smem + pr * (8 * L));
  f32x2* h2 = zz + 2 * L;
  f32x2* x2 = h2 + L;
  float* raw = (float*)smem + 2 * (8 * L);
  const float* U = (const float*)(pws(p, OFF_U));
  const float* cw = pin(p, I_CW) + l * 3 * 768;
  const float* cb = pin(p, I_CB) + l * 768;
  const float* filt = (const float*)(pws(p, OFF_FILT)) + (size_t)l * 1280 * 256 + (size_t)(NI == 1 ? 0 : 256) * 256;
  f32x2 w0a, w0b, w0c, b0, w1a, w1b, w1c, b1, w2a, w2b, w2c, b2;
#pragma unroll
  for (int e = 0; e < 2; ++e) {
    const int c = ca + e;
    w0a[e] = cw[c]; w0b[e] = cw[768 + c]; w0c[e] = cw[1536 + c]; b0[e] = cb[c];
    w1a[e] = cw[256 + c]; w1b[e] = cw[768 + 256 + c]; w1c[e] = cw[1536 + 256 + c]; b1[e] = cb[256 + c];
    w2a[e] = cw[512 + c]; w2b[e] = cw[768 + 512 + c]; w2c[e] = cw[1536 + 512 + c]; b2[e] = cb[512 + c];
  }
  __syncthreads();
  {
    const f32x2 zero = {0.f, 0.f};
    for (int i = lane + 64 * hf; i < L / 2; i += 128) { zz[i] = zero; zz[3 * L / 2 + i] = zero; }
  }
  for (int s = tid; s < L; s += 256) {
    const float4 f = *(const float4*)(filt + (size_t)s * 256 + c0);
    f32x2* hA = (f32x2*)((float*)smem) + 2 * L + s;
    f32x2* hB = (f32x2*)((float*)smem + 8 * L) + 2 * L + s;
    *hA = (f32x2){f.x, f.y};
    *hB = (f32x2){f.z, f.w};
  }
#pragma unroll 1
  for (int ch = 0; ch < NI; ++ch) {
    __syncthreads();
#pragma unroll
    for (int k = 0; k < 4; ++k) {
      const int idx = tid + 256 * k;
      if (idx < 774) {
        const int reg = idx / 258, row = idx - reg * 258;
        const int t = ch * 256 - 1 + row;
        float4 v = make_float4(0.f, 0.f, 0.f, 0.f);
        if (t >= 0 && t < L) v = *(const float4*)(U + (size_t)(tok0 + t) * NIN + 2064 + reg * 256 + c0);
        *(float4*)(raw + (size_t)idx * 4) = v;
      }
    }
    __syncthreads();
#pragma unroll
    for (int k = 0; k < 2; ++k) {
      const int tl = lane + 64 * k + 128 * hf, row = tl + 1;
      const f32x2* r0 = (const f32x2*)(raw + (0 * 258 + row) * 4 + 2 * pr);
      const f32x2* r1 = (const f32x2*)(raw + (1 * 258 + row) * 4 + 2 * pr);
      const f32x2* r2 = (const f32x2*)(raw + (2 * 258 + row) * 4 + 2 * pr);
      const f32x2 x0 = b0 + w0a * r0[-2] + w0b * r0[0] + w0c * r0[2];
      const f32x2 x1 = b1 + w1a * r1[-2] + w1b * r1[0] + w1c * r1[2];
      const f32x2 vv = b2 + w2a * r2[-2] + w2b * r2[0] + w2c * r2[2];
      const int t = ch * 256 + tl;
      zz[L / 2 + t] = x1 * vv;
      x2[t] = x0;
    }
  }
  __syncthreads();
  f32x2 acc[NH][4];
  float4 hi[NH][2];
  const float4* zz4 = (const float4*)__builtin_assume_aligned(zz, 16);
  const float4* h4p = (const float4*)__builtin_assume_aligned(h2, 16);
  const int gofs = (NI >= 2) ? NH * hf : 0;
#pragma unroll
  for (int i = 0; i < NH; ++i) {
#pragma unroll
    for (int j = 0; j < 4; ++j) acc[i][j] = (f32x2){0.f, 0.f};
    const int xb = 4 * lane + 256 * (gofs + i) + L;
    hi[i][0] = zz4[xb / 2];
    hi[i][1] = zz4[xb / 2 + 1];
  }
  const bool active = (NI >= 2) || (hf == 0);
  if (active) {
    float4 lo[NH][2], hq[2];
#pragma unroll
    for (int i = 0; i < NH; ++i) {
      const int xb = 4 * lane + 256 * (gofs + i) + L - 4;
      lo[i][0] = zz4[xb / 2];
      lo[i][1] = zz4[xb / 2 + 1];
    }
    hq[0] = h4p[0];
    hq[1] = h4p[1];
#pragma unroll 2
    for (int sg = 0; sg < L / 4; ++sg) {
      const int sn = (sg + 1 < L / 4) ? sg + 1 : sg;
      float4 nlo[NH][2], nhq[2];
#pragma unroll
      for (int i = 0; i < NH; ++i) {
        const int xb = 4 * lane + 256 * (gofs + i) + L - 4 * sn - 4;
        nlo[i][0] = zz4[xb / 2];
        nlo[i][1] = zz4[xb / 2 + 1];
      }
      nhq[0] = h4p[2 * sn];
      nhq[1] = h4p[2 * sn + 1];
      const f32x2 hh[4] = {(f32x2){hq[0].x, hq[0].y}, (f32x2){hq[0].z, hq[0].w}, (f32x2){hq[1].x, hq[1].y}, (f32x2){hq[1].z, hq[1].w}};
#pragma unroll
      for (int i = 0; i < NH; ++i) {
        const float4 lo0 = lo[i][0], lo1 = lo[i][1];
        const f32x2 w[8] = {(f32x2){lo0.x, lo0.y}, (f32x2){lo0.z, lo0.w}, (f32x2){lo1.x, lo1.y}, (f32x2){lo1.z, lo1.w},
                            (f32x2){hi[i][0].x, hi[i][0].y}, (f32x2){hi[i][0].z, hi[i][0].w},
                            (f32x2){hi[i][1].x, hi[i][1].y}, (f32x2){hi[i][1].z, hi[i][1].w}};
#pragma unroll
        for (int j = 0; j < 4; ++j) {
          f32x2 a = acc[i][j];
          a = __builtin_elementwise_fma(hh[0], w[4 + j], a);
          a = __builtin_elementwise_fma(hh[1], w[3 + j], a);
          a = __builtin_elementwise_fma(hh[2], w[2 + j], a);
          a = __builtin_elementwise_fma(hh[3], w[1 + j], a);
          acc[i][j] = a;
        }
        hi[i][0] = lo0;
        hi[i][1] = lo1;
        lo[i][0] = nlo[i][0];
        lo[i][1] = nlo[i][1];
      }
      hq[0] = nhq[0];
      hq[1] = nhq[1];
    }
  }
  f32x2 hb;
  hb[0] = pin(p, I_HBIAS)[l * 256 + ca];
  hb[1] = pin(p, I_HBIAS)[l * 256 + ca + 1];
  bf16_t* obuf = (bf16_t*)raw;
  if (active) {
#pragma unroll
    for (int i = 0; i < NH; ++i)
#pragma unroll
      for (int j = 0; j < 4; ++j) {
        const int t = 4 * lane + 256 * (gofs + i) + j;
        const f32x2 y = acc[i][j] + hb * zz[t + L / 2];
        const f32x2 o = x2[t] * y;
        *(unsigned*)(obuf + t * 4 + 2 * pr) = pack2(o[0], o[1]);
      }
  }
  __syncthreads();
  for (int t = tid; t < L; t += 256)
    *(uint2*)(YM + (size_t)(tok0 + t) * DM + 768 + c0) = *(const uint2*)(obuf + t * 4);
}

constexpr int FLAG_WORD0 = 3584;
DI void mlstm_dir_item(const Params& p, int l, bool lat, int bidx, int tok0, int L, int head, int dir, int* flag, char* smem) {
  const int tid = otid(), lane = tid & 63, g = lane >> 4, r16 = lane & 15;
  const int wid = __builtin_amdgcn_readfirstlane(tid >> 6);
  bf16_t* Qs = (bf16_t*)smem;
  bf16_t* Ks = Qs + 64 * 72;
  bf16_t* Vt = Ks + 64 * 72;
  bf16_t* Ct = Vt + 64 * 72;
  float* vec = (float*)(smem + 4 * 9216);
  float* v_d1 = vec + 320;
  float* S_bc = (float*)(smem + 4 * 9216 + 4096);
  float* S_amb = S_bc + 1024;
  float* S_mt = S_amb + 1024;
  float* S_wi = S_mt + 1024;
  float* S_wk = S_wi + 1024;
  float* S_btot = S_wk + 1024;
  float* S_mx = S_btot + 16;
  float* S_dec = S_mx + 16;
  float* S_mnew = S_dec + 16;
  float* v_d2 = vec + 384;
  float* v_np = vec + 640;
  float* v_n = vec + 896;
  float* v_sc = vec + 960;
  const float* U = (const float*)(pws(p, OFF_U));
  float* HD = (float*)(pws(p, dir == 0 ? OFF_HF : OFF_HB));
  const int nc = L / 64;
  const float gbi = pin(p, I_BG)[l * 16 + dir * 4 + head];
  const float gbf = pin(p, I_BG)[l * 16 + 8 + dir * 4 + head];
  const size_t sidx = ((size_t)((bidx * 2 + l) * 2 + dir)) * 4 + head;

  f32x4 cacc[4];
  __syncthreads();
  if (lat) {
    const float* sc = pin(p, I_SC) + sidx * 4096;
#pragma unroll
    for (int et = 0; et < 4; ++et)
#pragma unroll
      for (int j = 0; j < 4; ++j) cacc[et][j] = sc[(wid * 16 + g * 4 + j) * 64 + et * 16 + r16];
    if (tid < 64) v_n[tid] = pin(p, I_SN)[sidx * 64 + tid];
    if (tid == 0) v_sc[0] = pin(p, I_SM)[sidx];
  } else {
#pragma unroll
    for (int et = 0; et < 4; ++et) cacc[et] = (f32x4){0.f, 0.f, 0.f, 0.f};
    if (tid < 64) v_n[tid] = 0.f;
    if (tid == 0) v_sc[0] = 0.f;
  }
#pragma unroll
  for (int et = 0; et < 4; ++et)
    *(uint2*)(Ct + (et * 16 + r16) * 72 + wid * 16 + g * 4) =
        make_uint2(pack2(cacc[et][0], cacc[et][1]), pack2(cacc[et][2], cacc[et][3]));

  for (int c = wid; c < nc; c += 4) {
    const int pos = c * 64 + lane;
    const int tok = tok0 + (dir == 0 ? pos : L - 1 - pos);
    const float igv = U[(size_t)tok * NIN + 1024 + dir * 4 + head] + gbi;
    const float fgv = U[(size_t)tok * NIN + 1032 + dir * 4 + head] + gbf;
    const float lf = fminf(fgv, 0.f) - __logf(1.f + __expf(-fabsf(fgv)));
    float bc = lf;
#pragma unroll
    for (int o = 1; o < 64; o <<= 1) {
      float up = __shfl_up(bc, o);
      if (lane >= o) bc += up;
    }
    const float amb = igv - bc;
    float pm = amb;
#pragma unroll
    for (int o = 1; o < 64; o <<= 1) {
      float up = __shfl_up(pm, o);
      if (lane >= o) pm = fmaxf(pm, up);
    }
    const float btot = __shfl(bc, 63);
    const float wlog = btot - bc + igv;
    float mx = wlog;
    mx = fmaxf(mx, shx<32>(mx)); mx = fmaxf(mx, shx<16>(mx)); mx = fmaxf(mx, shx<8>(mx));
    mx = fmaxf(mx, shx<4>(mx)); mx = fmaxf(mx, shx<2>(mx)); mx = fmaxf(mx, shx<1>(mx));
    S_bc[c * 64 + lane] = bc;
    S_amb[c * 64 + lane] = amb;
    S_mt[c * 64 + lane] = bc + pm;
    S_wk[c * 64 + lane] = wlog;
    if (lane == 0) { S_btot[c] = btot; S_mx[c] = mx; }
  }
  __syncthreads();
  if (wid == 0) {
    float m_old = v_sc[0];
    for (int c = 0; c < nc; ++c) {
      const float bc = S_bc[c * 64 + lane];
      const float inter = bc + m_old;
      const float mt = fmaxf(S_mt[c * 64 + lane], inter);
      const float btot = S_btot[c];
      const float m_new = fmaxf(btot + m_old, S_mx[c]);
      S_mt[c * 64 + lane] = mt;
      S_wi[c * 64 + lane] = __expf(inter - mt);
      S_wk[c * 64 + lane] = __expf(S_wk[c * 64 + lane] - m_new);
      if (lane == 0) { S_dec[c] = __expf(btot + m_old - m_new); S_mnew[c] = m_new; }
      m_old = m_new;
    }
  }
  __syncthreads();
  float4 pq[4], pk4[4], pv4[4];
#define MLSTM_FETCH(ci_)                                                                                             \
  do {                                                                                                               \
    _Pragma("unroll") for (int j = 0; j < 4; ++j) {                                                                  \
      const int cidx = tid + 256 * j, row = cidx >> 4, d4 = (cidx & 15) * 4;                                         \
      const int pos = (ci_) * 64 + row;                                                                              \
      const int tok = tok0 + (dir == 0 ? pos : L - 1 - pos);                                                         \
      const float* ur = U + (size_t)tok * NIN + head * 64 + d4;                                                      \
      pq[j] = *(const float4*)(ur);                                                                                  \
      pk4[j] = *(const float4*)(ur + 256);                                                                           \
      pv4[j] = *(const float4*)(ur + 512);                                                                           \
    }                                                                                                                \
  } while (0)
  MLSTM_FETCH(0);
  for (int ci = 0; ci < nc; ++ci) {
#pragma unroll
    for (int j = 0; j < 4; ++j) {
      const int cidx = tid + 256 * j, row = cidx >> 4, d4 = (cidx & 15) * 4;
      const float4 qv = pq[j], kv = pk4[j], vv = pv4[j];
      *(uint2*)(Qs + row * 72 + d4) = make_uint2(pack2(qv.x, qv.y), pack2(qv.z, qv.w));
      *(uint2*)(Ks + row * 72 + d4) =
          make_uint2(pack2(kv.x * 0.125f, kv.y * 0.125f), pack2(kv.z * 0.125f, kv.w * 0.125f));
      Vt[(d4 + 0) * 72 + row] = f2bf(vv.x);
      Vt[(d4 + 1) * 72 + row] = f2bf(vv.y);
      Vt[(d4 + 2) * 72 + row] = f2bf(vv.z);
      Vt[(d4 + 3) * 72 + row] = f2bf(vv.w);
    }
    if (ci + 1 < nc) MLSTM_FETCH(ci + 1);
    const float* v_bc = S_bc + ci * 64;
    const float* v_amb = S_amb + ci * 64;
    const float* v_mt = S_mt + ci * 64;
    const float* v_wi = S_wi + ci * 64;
    const float* v_wk = S_wk + ci * 64;
    __syncthreads();
    f32x4 sp[4];
    unsigned n2k[4][2], spk[4][2];
    {
      bf16x8 qa[2];
#pragma unroll
      for (int ds = 0; ds < 2; ++ds) qa[ds] = *(const bf16x8*)(Qs + (wid * 16 + r16) * 72 + ds * 32 + g * 8);
#pragma unroll
      for (int st = 0; st < 4; ++st) {
        bf16x8 kb0 = *(const bf16x8*)(Ks + (st * 16 + r16) * 72 + g * 8);
        bf16x8 kb1 = *(const bf16x8*)(Ks + (st * 16 + r16) * 72 + 32 + g * 8);
        bf16x8 cb0 = *(const bf16x8*)(Ct + (st * 16 + r16) * 72 + g * 8);
        bf16x8 cb1 = *(const bf16x8*)(Ct + (st * 16 + r16) * 72 + 32 + g * 8);
        f32x4 z = (f32x4){0.f, 0.f, 0.f, 0.f};
        z = MFMA16(qa[0], kb0, z);
        sp[st] = MFMA16(qa[1], kb1, z);
        f32x4 y = (f32x4){0.f, 0.f, 0.f, 0.f};
        y = MFMA16(qa[0], cb0, y);
        y = MFMA16(qa[1], cb1, y);
        n2k[st][0] = pack2(y[0], y[1]);
        n2k[st][1] = pack2(y[2], y[3]);
      }
    }
    {
      float s = 0.f;
#pragma unroll
      for (int d = 0; d < 16; ++d) s += bf2f(Qs[lane * 72 + wid * 16 + d]) * v_n[wid * 16 + d];
      v_d2[wid * 64 + lane] = s;
    }
#pragma unroll
    for (int j = 0; j < 4; ++j) {
      const int t = wid * 16 + g * 4 + j;
      const float bt = v_bc[t] - v_mt[t];
      float rs = 0.f;
#pragma unroll
      for (int st = 0; st < 4; ++st) {
        const int s = st * 16 + r16;
        float wgt = (s <= t) ? __expf(bt + v_amb[s]) : 0.f;
        float val = sp[st][j] * wgt;
        sp[st][j] = val;
        rs += val;
      }
      rs += shx<1>(rs); rs += shx<2>(rs); rs += shx<4>(rs); rs += shx<8>(rs);
      if (r16 == 0) v_d1[t] = rs;
    }
#pragma unroll
    for (int st = 0; st < 4; ++st) {
      spk[st][0] = pack2(sp[st][0], sp[st][1]);
      spk[st][1] = pack2(sp[st][2], sp[st][3]);
    }
    __syncthreads();
    bf16_t* Sp = Qs;
    bf16_t* KwT = Ct;
#pragma unroll
    for (int st = 0; st < 4; ++st)
#pragma unroll
      for (int j = 0; j < 4; ++j)
        Sp[(wid * 16 + g * 4 + j) * 72 + st * 16 + r16] =
            (bf16_t)((j & 1) ? (spk[st][j >> 1] >> 16) : (spk[st][j >> 1] & 0xffffu));
    {
      const int s = tid & 63, dq = (tid >> 6) * 16;
      const float wk = v_wk[s];
#pragma unroll
      for (int d8 = 0; d8 < 2; ++d8) {
        bf16x8 kk = *(const bf16x8*)(Ks + s * 72 + dq + d8 * 8);
#pragma unroll
        for (int i = 0; i < 8; ++i) KwT[(dq + d8 * 8 + i) * 72 + s] = f2bf(bf2f((bf16_t)kk[i]) * wk);
      }
    }
    const float decay = S_dec[ci];
    {
      float s = 0.f;
#pragma unroll
      for (int q = 0; q < 16; ++q) s += v_wk[wid * 16 + q] * bf2f(Ks[(wid * 16 + q) * 72 + lane]);
      v_np[wid * 64 + lane] = s;
    }
    __syncthreads();
    if (wid == 0) v_n[lane] = decay * v_n[lane] + (v_np[lane] + v_np[64 + lane]) + (v_np[128 + lane] + v_np[192 + lane]);
    {
      bf16x8 sa[2], ka[2];
#pragma unroll
      for (int ks = 0; ks < 2; ++ks) {
        sa[ks] = *(const bf16x8*)(Sp + (wid * 16 + r16) * 72 + ks * 32 + g * 8);
        ka[ks] = *(const bf16x8*)(KwT + (wid * 16 + r16) * 72 + ks * 32 + g * 8);
      }
      float wi[4], dn[4];
      int tokr[4];
#pragma unroll
      for (int j = 0; j < 4; ++j) {
        const int t = wid * 16 + g * 4 + j;
        wi[j] = v_wi[t];
        float den = v_d1[t] + wi[j] * (v_d2[t] + v_d2[64 + t] + v_d2[128 + t] + v_d2[192 + t]);
        dn[j] = 1.f / fmaxf(fabsf(den), __expf(-v_mt[t]));
        const int pos = ci * 64 + t;
        tokr[j] = tok0 + (dir == 0 ? pos : L - 1 - pos);
      }
#pragma unroll
      for (int et = 0; et < 4; ++et) {
        bf16x8 vb0 = *(const bf16x8*)(Vt + (et * 16 + r16) * 72 + g * 8);
        bf16x8 vb1 = *(const bf16x8*)(Vt + (et * 16 + r16) * 72 + 32 + g * 8);
        f32x4 z = (f32x4){0.f, 0.f, 0.f, 0.f};
        z = MFMA16(sa[0], vb0, z);
        z = MFMA16(sa[1], vb1, z);
#pragma unroll
        for (int j = 0; j < 4; ++j) {
          float n2v = __uint_as_float((j & 1) ? (n2k[et][j >> 1] & 0xffff0000u) : (n2k[et][j >> 1] << 16));
          float hv = (z[j] + wi[j] * n2v) * dn[j];
          HD[(size_t)tokr[j] * 256 + head * 64 + et * 16 + r16] = hv;
        }
        f32x4 cc = cacc[et] * decay;
        cc = MFMA16(ka[0], vb0, cc);
        cacc[et] = MFMA16(ka[1], vb1, cc);
      }
    }
    __syncthreads();
#pragma unroll
    for (int et = 0; et < 4; ++et)
      *(uint2*)(Ct + (et * 16 + r16) * 72 + wid * 16 + g * 4) =
          make_uint2(pack2(cacc[et][0], cacc[et][1]), pack2(cacc[et][2], cacc[et][3]));
  }
#undef MLSTM_FETCH
  if (!lat) {
    float* oc = pout(p) + O_NC + sidx * 4096;
#pragma unroll
    for (int et = 0; et < 4; ++et)
#pragma unroll
      for (int j = 0; j < 4; ++j) oc[(wid * 16 + g * 4 + j) * 64 + et * 16 + r16] = cacc[et][j];
    if (wid == 0) pout(p)[O_NN + sidx * 64 + lane] = v_n[lane];
    if (tid == 0) pout(p)[O_NM + sidx] = S_mnew[nc - 1];
  }
  asm volatile("s_waitcnt vmcnt(0)" ::: "memory");
  __syncthreads();
  if (tid == 0) {
    __builtin_amdgcn_fence(__ATOMIC_RELEASE, "agent");
    asm volatile("s_waitcnt vmcnt(0)" ::: "memory");
    __hip_atomic_fetch_add(flag, 1, __ATOMIC_RELAXED, __HIP_MEMORY_SCOPE_AGENT);
  }
}

DI void mlstm_combine_item(const Params& p, int l, int tok0, int head, int* flag, bf16_t* YM) {
  const int tid = otid();
  if (tid == 0) {
    unsigned spins = 0;
    while (__hip_atomic_load(flag, __ATOMIC_RELAXED, __HIP_MEMORY_SCOPE_AGENT) < 2) {
      __builtin_amdgcn_s_sleep(2);
      if (++spins > (1u << 22)) break;
    }
    __builtin_amdgcn_fence(__ATOMIC_ACQUIRE, "agent");
    asm volatile("s_waitcnt vmcnt(0)" ::: "memory");
  }
  __syncthreads();
  const float* U = (const float*)(pws(p, OFF_U));
  const float* HF = (const float*)(pws(p, OFF_HF));
  const float* HB = (const float*)(pws(p, OFF_HB));
  const float* gm = pin(p, I_GML) + l * 256 + head * 64;
  const int i16 = tid & 15;
#pragma unroll 4
  for (int tt = tid >> 4; tt < 256; tt += 16) {
    const size_t tok = tok0 + tt;
    float4 a = *(const float4*)(HF + tok * 256 + head * 64 + i16 * 4);
    float4 b = *(const float4*)(HB + tok * 256 + head * 64 + i16 * 4);
    float h0 = a.x + b.x, h1 = a.y + b.y, h2 = a.z + b.z, h3 = a.w + b.w;
    float ss = h0 * h0 + h1 * h1 + h2 * h2 + h3 * h3;
    ss += shx<1>(ss); ss += shx<2>(ss); ss += shx<4>(ss); ss += shx<8>(ss);
    const float r = rsqrtf(ss * (1.0f / 64.0f) + EPS);
    float4 ov = *(const float4*)(U + tok * NIN + 768 + head * 64 + i16 * 4);
    float4 gg = *(const float4*)(gm + i16 * 4);
    float y0 = h0 * r * gg.x * sigmoidf_(ov.x);
    float y1 = h1 * r * gg.y * sigmoidf_(ov.y);
    float y2 = h2 * r * gg.z * sigmoidf_(ov.z);
    float y3 = h3 * r * gg.w * sigmoidf_(ov.w);
    *(uint2*)(YM + tok * DM + head * 64 + i16 * 4) = make_uint2(pack2(y0, y1), pack2(y2, y3));
  }
}

DI void phase_mixer(const Params& p, int lc, int kindmask, char* smem) {
  __shared__ int s_item;
  int* ctr = (int*)(pws(p, OFF_BAR)) + lc;
  const int l = lc & 1;
  bf16_t* YM = (bf16_t*)(pws(p, OFF_H));
  const bf16_t* QB = (const bf16_t*)(pws(p, OFF_QB));
  const bf16_t* QC = (const bf16_t*)(pws(p, OFF_QC));
  const bf16_t* KB = (const bf16_t*)(pws(p, OFF_KB));
  const bf16_t* VB = (const bf16_t*)(pws(p, OFF_VB));
  const bf16_t* KC = (const bf16_t*)(pws(p, OFF_KC));
  const bf16_t* VC = (const bf16_t*)(pws(p, OFF_VC));
  const int total = 32 + 128 + 256 + 128 + 128 + 128 + 128 + 1024 + 128;
  int* flags = (int*)(pws(p, OFF_BAR)) + FLAG_WORD0 + l * 80;
  while (true) {
    __syncthreads();
    if (otid() == 0) s_item = atomicAdd(ctr, 1);
    __syncthreads();
    int it = __builtin_amdgcn_readfirstlane(s_item);
    if (it >= total) break;
    int kind;
    bool lat = false, gl = false;
    int a0 = 0, a1 = 0, a2 = 0;
    if (it < 32) { kind = 0; lat = true; a0 = it >> 3; a1 = (it >> 1) & 3; a2 = it & 1; }
    else if ((it -= 32) < 128) { kind = 1; lat = true; gl = true; a0 = it >> 5; a1 = (it >> 3) & 3; a2 = it & 7; }
    else if ((it -= 128) < 256) { kind = 2; a0 = it >> 6; a1 = it & 63; }
    else if ((it -= 256) < 128) { kind = 1; lat = true; gl = false; a0 = it >> 5; a1 = (it >> 3) & 3; a2 = it & 7; }
    else if ((it -= 128) < 128) { kind = 0; lat = false; a0 = it >> 3; a1 = (it >> 1) & 3; a2 = it & 1; }
    else if ((it -= 128) < 128) { kind = 1; lat = false; gl = true; a0 = it >> 3; a1 = (it >> 1) & 3; a2 = it & 1; }
    else if ((it -= 128) < 128) { kind = 1; lat = false; gl = false; a0 = it >> 3; a1 = (it >> 1) & 3; a2 = it & 1; }
    else if ((it -= 128) < 1024) { kind = 3; a0 = it >> 6; a1 = it & 63; }
    else { it -= 1024; kind = 4; }
    if (kind == 4) {
      int tok0c, headc, fidx;
      if (it < 64) { const int sq = it >> 4; headc = (it >> 2) & 3; tok0c = NCTX + sq * 1024 + (it & 3) * 256; fidx = sq * 4 + headc; }
      else { const int sq = (it - 64) >> 2; headc = (it - 64) & 3; tok0c = sq * 256; fidx = 16 + sq * 4 + headc; }
      mlstm_combine_item(p, l, tok0c, headc, flags + fidx, YM);
      continue;
    }
    if (!((kindmask >> kind) & 1)) continue;
    if (kind == 0) {
#ifndef SKIP_MLSTM
      mlstm_dir_item(p, l, lat, a0, lat ? NCTX + a0 * 1024 : a0 * 256, lat ? 1024 : 256, a1, a2,
                     flags + (lat ? a0 * 4 + a1 : 16 + a0 * 4 + a1), smem);
#endif
    } else if (kind == 1) {
      const int head = a1, qb = a2;
      const int tok0 = lat ? NCTX + a0 * 1024 : a0 * 256;
      const size_t kr = (size_t)(lat ? NCTX + a0 * 1280 : tok0) * 128 + (head >> 1) * 64;
      int n1, start2 = 0, n2 = 0;
      if (lat && gl) n1 = 20;
      else if (lat) {
        const int lo = 2 * qb - 2 < 0 ? 0 : 2 * qb - 2, hi = 2 * qb + 3 > 15 ? 15 : 2 * qb + 3;
        n1 = 4; start2 = 4 + lo; n2 = hi - lo + 1;
      } else n1 = 4;
      const float sink = gl ? 0.f : pin(p, I_SINK)[l * 4 + head];
      attn_item((gl ? QB : QC) + (size_t)tok0 * 256 + head * 64, (gl ? KB : KC) + kr, (gl ? VB : VC) + kr, qb * 128, n1,
                start2, n2, lat && !gl, !gl, sink, YM + (size_t)tok0 * DM + (gl ? 256 : 512) + head * 64, smem);
    } else if (kind == 2) {
#ifndef SKIP_HYENA
      hyena_item<4>(p, l, NCTX + a0 * 1024, a1, YM, smem);
#endif
    } else {
#ifndef SKIP_HYENA
      hyena_item<1>(p, l, a0 * 256, a1, YM, smem);
#endif
    }
  }
}

__global__ void __launch_bounds__(256, 2) trunk_megakernel(Params p) {
  extern __shared__ __attribute__((aligned(16))) char smem[];
  cg::grid_group grid = cg::this_grid();
  __shared__ uint4 xb_words;
  if (threadIdx.x == 0) xb_words = make_uint4(0u, 0u, 0u, 0u);
  __syncthreads();
  if (p.out == nullptr) grid.sync();
  XcdBarrier xb = xcd_barrier_post((unsigned*)(pws(p, OFF_BAR)), (volatile LAS unsigned*)&xb_words);

#pragma unroll 1
  for (int ph = 0; ph < 24; ++ph) {
    const bf16_t* WT = (const bf16_t*)(pws(p, OFF_WT));
    const bf16_t* H = (const bf16_t*)(pws(p, OFF_H));
    float* X = (float*)(pws(p, OFF_X));
    float* U = (float*)(pws(p, OFF_U));
    bf16_t* ACT = (bf16_t*)(pws(p, OFF_U));
    const float* MOD = (const float*)(pws(p, OFF_MOD));
    if (ph == 0) {
#pragma unroll 1
      for (int rep = 0; rep < REP_PRO; ++rep) phase_prologue(p, smem);
    } else if (ph == 23) {
      phase_final_norm(p);
    } else {
      const int l = (ph - 1) / 11, s = (ph - 1) % 11;
      const float* modl = MOD + (size_t)l * 5 * NMOD;
      if (s == 0 || s == 3 || s == 8) {
        const float* g = (s == 0 ? pin(p, I_GFF1) : s == 3 ? pin(p, I_GMIX) : pin(p, I_GFF2)) + l * DM;
        const int ps = (s == 0) ? 0 : (s == 3) ? 3 : 6;
#pragma unroll 1
        for (int rep = 0; rep < REP_SMALL; ++rep)
          phase_norm(p, l, l == 0 && s == 0, g, ps, ps + 1);
        if (s == 0 && l == 1) {
#pragma unroll 1
          for (int rep = 0; rep < REP_PRO; ++rep) convert_layer(p, 1, smem);
        }
      } else if (s == 1 || s == 9) {
        EpiArgs ea{ACT, nullptr, nullptr, nullptr, 0.f};
#ifndef REP_GEMM
#define REP_GEMM 1
#endif
#pragma unroll 1
        for (int rep = 0; rep < REP_GEMM; ++rep)
        {
          gemm_k64<EPI_GU>(H, DM, WT + (s == 1 ? WT_GU1 : WT_GU2), DM, NTOK, NGU, DM, ea, smem);
        }
      } else if (s == 2 || s == 7 || s == 10) {
        const bool first = (l == 0 && s == 2);
        EpiArgs ea{X, first ? pin(p, I_XP) : X, first ? pin(p, I_XS) : X + (size_t)NCTX * DM,
                   modl + (s == 2 ? 2 : s == 7 ? 5 : 8) * 1024, s == 7 ? 1.0f : 0.5f};
        const bf16_t* A = (s == 7) ? H : ACT;
        const int K = (s == 7) ? DM : DFF;
        const bf16_t* B = WT + (s == 2 ? WT_D1 : s == 7 ? WT_OUT : WT_D2);
        gemm_k64<EPI_RES>(A, K, B, K, NTOK, DM, K, ea, smem);
#if REP_RES > 1
        {
          xcd_barrier(xb);
          EpiArgs eb{X, X, X + (size_t)NCTX * DM, ea.modp, 0.0f};
          gemm_k64<EPI_RES>(A, K, B, K, NTOK, DM, K, eb, smem);
        }
#endif
      } else if (s == 4) {
        EpiArgs ea{U, nullptr, nullptr, nullptr, 0.f};
#pragma unroll 1
        for (int rep = 0; rep < REP_GEMM; ++rep)
          gemm_k64<EPI_U>(H, DM, WT + WT_IN, DM, NTOK, NIN, DM, ea, smem);
      } else if (s == 5) {
#ifndef REP_SMALL
#define REP_SMALL 1
#endif
#pragma unroll 1
        for (int rep = 0; rep < REP_SMALL; ++rep)
          phase_prep(p, l);
      } else {
#ifndef REP_MIXER
#define REP_MIXER 1
#endif
#pragma unroll 1
        for (int rep = 0; rep < REP_MIXER; ++rep)
          phase_mixer(p, l + 2 * rep, rep == 0 ? 15 : REP_MASK, smem);
      }
    }
    if (ph < 23) {
      xcd_barrier(xb);
#if REP_BAR > 1
      xcd_barrier(xb);
#endif
    }
  }
}

extern "C" void kernel_launch(void* const* d_in, const int* in_sizes, int n_in, void* d_out, int out_size, void* d_ws,
                              size_t ws_size, hipStream_t stream) {
  static int grid_blocks = 0;
  if (!grid_blocks) {
    int dev = 0, cus = 0, per_cu = 0;
    hipGetDevice(&dev);
    hipDeviceGetAttribute(&cus, hipDeviceAttributeMultiprocessorCount, dev);
    hipFuncSetAttribute((const void*)trunk_megakernel, hipFuncAttributeMaxDynamicSharedMemorySize, LDS_BYTES);
    hipOccupancyMaxActiveBlocksPerMultiprocessor(&per_cu, trunk_megakernel, 256, LDS_BYTES);
    if (per_cu > 2) per_cu = 2;
    if (per_cu < 1) per_cu = 1;
    grid_blocks = cus * per_cu;
  }
  Params p{};
  for (int i = 0; i < 40; ++i) p.in[i] = (const float*)d_in[i];
  p.out = (float*)d_out;
  p.ws = (char*)d_ws;
  hipMemsetAsync((char*)d_ws + OFF_BAR, 0, 16384, stream);
  void* args[] = {&p};
  hipError_t e = hipLaunchCooperativeKernel((void*)trunk_megakernel, dim3(grid_blocks), dim3(256), args, LDS_BYTES, stream);
  if (e != hipSuccess) fprintf(stderr, "cooperative launch failed: %s (grid %d)\n", hipGetErrorString(e), grid_blocks);
}

#ifdef PROBE_PHASES
__global__ void __launch_bounds__(256, 2) k_mod(Params p) { extern __shared__ __attribute__((aligned(16))) char smem[]; mod_item(p, blockIdx.x, smem); }
__global__ void __launch_bounds__(256, 2) k_filt(Params p) { extern __shared__ __attribute__((aligned(16))) char smem[]; filt_item(p, blockIdx.x, smem); }
__global__ void __launch_bounds__(256, 2) k_conv(Params p) { extern __shared__ __attribute__((aligned(16))) char smem[]; convert_layer(p, 0, smem); }
__global__ void __launch_bounds__(256, 2) k_pro(Params p) { extern __shared__ __attribute__((aligned(16))) char smem[]; phase_prologue(p, smem); }
__global__ void __launch_bounds__(256, 2) k_norm(Params p) { phase_norm(p, 0, true, p.in[I_GFF1], 0, 1); }
__global__ void __launch_bounds__(256, 2) k_gemm_gu(Params p) { extern __shared__ __attribute__((aligned(16))) char smem[]; EpiArgs ea{p.ws, nullptr, nullptr, nullptr, 0.f}; gemm_phase<EPI_GU>((bf16_t*)p.ws, DM, (bf16_t*)p.ws, DM, NTOK, NGU, DM, ea, smem); }
__global__ void __launch_bounds__(256, 2) k_gemm_res(Params p) { extern __shared__ __attribute__((aligned(16))) char smem[]; EpiArgs ea{p.ws, p.in[0], p.in[1], p.in[2], 0.5f}; gemm_phase<EPI_RES>((bf16_t*)p.ws, DM, (bf16_t*)p.ws, DM, NTOK, DM, DM, ea, smem); }
__global__ void __launch_bounds__(256, 2) k_gemm_u(Params p) { extern __shared__ __attribute__((aligned(16))) char smem[]; EpiArgs ea{p.ws, nullptr, nullptr, nullptr, 0.f}; gemm_phase<EPI_U>((bf16_t*)p.ws, DM, (bf16_t*)p.ws, DM, NTOK, NIN, DM, ea, smem); }
__global__ void __launch_bounds__(256, 2) k_prep(Params p) { phase_prep(p, 0); }
__global__ void __launch_bounds__(256, 2) k_attn(Params p, int a, int b, int c, int d, bool w, bool hs, float sk) { extern __shared__ __attribute__((aligned(16))) char smem[]; attn_item((bf16_t*)p.ws, (bf16_t*)p.ws, (bf16_t*)p.ws, a, b, c, d, w, hs, sk, (bf16_t*)p.ws, smem); }
__global__ void __launch_bounds__(256, 2) k_hy4(Params p) { extern __shared__ __attribute__((aligned(16))) char smem[]; hyena_item<4>(p, 0, 0, blockIdx.x, (bf16_t*)p.ws, smem); }
__global__ void __launch_bounds__(256, 2) k_hy1(Params p) { extern __shared__ __attribute__((aligned(16))) char smem[]; hyena_item<1>(p, 0, 0, blockIdx.x, (bf16_t*)p.ws, smem); }
__global__ void __launch_bounds__(256, 2) k_mixer(Params p) { extern __shared__ __attribute__((aligned(16))) char smem[]; phase_mixer(p, 0, 15, smem); }
#endif
```

```cpp
#include <hip/hip_runtime.h>
#include <hip/hip_cooperative_groups.h>
#include <cstdio>
namespace cg = cooperative_groups;

#define DI __device__ __forceinline__
typedef unsigned short bf16_t;
using bf16x8 = __attribute__((ext_vector_type(8))) short;
using bf16x4 = __attribute__((ext_vector_type(4))) short;
using f32x4 = __attribute__((ext_vector_type(4))) float;

constexpr int NTOK = 8192, NCTX = 4096, DM = 1024, DFF = 2816, NIN = 2832, NGU = 5632;
constexpr int NMOD = 9216;
constexpr float EPS = 1e-6f;

enum { I_XP = 0, I_XS, I_SC, I_SN, I_SM, I_CGK, I_CGV, I_CSK, I_CSV, I_C, I_CCTX, I_WADA, I_BADA, I_GFF1,
       I_W1G, I_W1U, I_W1D, I_GMIX, I_WIN, I_BG, I_GML, I_GQN, I_GKN, I_SINK, I_CW, I_CB, I_FW1, I_FB1,
       I_FW2, I_FB2, I_FW3, I_FB3, I_FFR, I_HBIAS, I_WOUT, I_GFF2, I_W2G, I_W2U, I_W2D, I_GFIN };

constexpr size_t O_Y = 0, O_NC = 8388608, O_NN = 9437184, O_NM = 9453568, O_GK = 9453824, O_GV = 10502400,
                 O_SK = 11550976, O_SV = 12599552;

constexpr size_t MiB = 1u << 20;
constexpr size_t OFF_WT = 0, OFF_X = 44 * MiB, OFF_H = 76 * MiB, OFF_U = 92 * MiB, OFF_QB = 181 * MiB,
                 OFF_QC = 185 * MiB, OFF_KB = 189 * MiB, OFF_VB = 192 * MiB, OFF_KC = 195 * MiB, OFF_VC = 198 * MiB,
                 OFF_HF = 201 * MiB, OFF_HB = 209 * MiB, OFF_MOD = 217 * MiB, OFF_FILT = 218 * MiB,
                 OFF_ROPE = 221 * MiB, OFF_CTR = 222 * MiB, OFF_BAR = 223 * MiB;
constexpr size_t WT_GU1 = 0, WT_D1 = 5767168, WT_IN = 8650752, WT_OUT = 11550720, WT_GU2 = 12599296, WT_D2 = 18366464;

#ifndef REP_GEMM
#define REP_GEMM 1
#endif
#ifndef REP_MIXER
#define REP_MIXER 1
#endif
#ifndef REP_SMALL
#define REP_SMALL 1
#endif
#ifndef REP_PRO
#define REP_PRO 1
#endif
#define REP_RES 1
#define REP_MASK 15
#define REP_BAR 1
constexpr int LDS_BYTES = 79 * 1024;

struct Params {
  const float* in[40];
  float* out;
  char* ws;
};

DI const float* pin(const Params& p, int i) {
  asm volatile("" : "+s"(i));
  return p.in[i];
}
DI char* pws(const Params& p, size_t off) {
  asm volatile("" : "+s"(off));
  return p.ws + off;
}
DI float* pout(const Params& p) {
  int z = 0;
  asm volatile("" : "+s"(z));
  return p.out + z;
}
DI int otid() {
  int t = threadIdx.x;
  asm volatile("" : "+v"(t));
  return t;
}
DI int obid() {
  int b = blockIdx.x;
  asm volatile("" : "+s"(b));
  return b;
}
DI bf16_t f2bf(float x) {
  unsigned u = __float_as_uint(x);
  u += 0x7fffu + ((u >> 16) & 1u);
  return (bf16_t)(u >> 16);
}
DI float bf2f(bf16_t h) { return __uint_as_float(((unsigned)h) << 16); }
DI unsigned pack2(float a, float b) { return (unsigned)f2bf(a) | ((unsigned)f2bf(b) << 16); }
template <int K>
DI float shx(float v) {
  if constexpr (K < 32) return __int_as_float(__builtin_amdgcn_ds_swizzle(__float_as_int(v), (K << 10) | 0x1f));
  else return __shfl_xor(v, K);
}
DI float wave_sum(float v) {
  v += shx<32>(v); v += shx<16>(v); v += shx<8>(v); v += shx<4>(v); v += shx<2>(v); v += shx<1>(v);
  return v;
}
DI float sigmoidf_(float x) { return 1.f / (1.f + __expf(-x)); }
DI int mod_index(int row) { return row < NCTX ? 0 : 1 + ((row - NCTX) >> 10); }
#define MFMA16(a, b, c) __builtin_amdgcn_mfma_f32_16x16x32_bf16((a), (b), (c), 0, 0, 0)


#define XB_TMO      128
#define XB_XCNT(j)  (256  + 64 * (j))
#define XB_XSUB(j)  (1280 + 64 * (j))
#define XB_XGEN(j)  (2304 + 64 * (j))
#define XB_TOP      3328
#define XB_TOPGEN   3392
#define XCD_BAR_WORDS 3456
#define XB_SPIN_CAP (1u << 20)
#define LAS __attribute__((address_space(3)))
DI unsigned xb_ld(unsigned* p) { return __hip_atomic_load(p, __ATOMIC_RELAXED, __HIP_MEMORY_SCOPE_AGENT); }
DI unsigned xb_add(unsigned* p, unsigned v) { return __hip_atomic_fetch_add(p, v, __ATOMIC_RELAXED, __HIP_MEMORY_SCOPE_AGENT); }
DI unsigned xb_xcc_id() { return (unsigned)__builtin_amdgcn_s_getreg((3 << 11) | 20) & 0xFu; }
#define XB_SPIN(cond, bar) do { unsigned _sp = 0; while (cond) { __builtin_amdgcn_s_sleep(1); \
    if ((++_sp & 255u) == 0u) { if (xb_ld(&(bar)[XB_TMO])) break; if (_sp > XB_SPIN_CAP) { atomicAdd(&(bar)[XB_TMO], 1u); break; } } } } while (0)
struct XcdBarrier {
  unsigned* bar; unsigned x;
  volatile LAS unsigned* st;
};
DI XcdBarrier xcd_barrier_post(unsigned* bar, volatile LAS unsigned* st) {
  XcdBarrier b; b.bar = bar; b.x = xb_xcc_id(); b.st = st;
  if (threadIdx.x == 0) (void)xb_add(&bar[XB_XCNT(b.x)], 1u);
  return b;
}
DI void xcd_barrier_complete(unsigned* bar, unsigned x, unsigned& nloc, unsigned& nx) {
  const unsigned G = gridDim.x * gridDim.y * gridDim.z;
  unsigned sum, cnt, mine, sp = 0u;
  for (;;) {
    sum = 0u; cnt = 0u; mine = 0u;
#pragma unroll 1
    for (unsigned j = 0; j < 16; ++j) { const unsigned c = xb_ld(&bar[XB_XCNT(j)]); sum += c; cnt += (c > 0u) ? 1u : 0u; mine = (j == x) ? c : mine; }
    if (sum == G) break;
    __builtin_amdgcn_s_sleep(1);
    if ((++sp & 255u) == 0u) { if (xb_ld(&bar[XB_TMO])) break; if (sp > XB_SPIN_CAP) { atomicAdd(&bar[XB_TMO], 1u); break; } }
  }
  nloc = mine > 0u ? mine : 1u; nx = cnt > 0u ? cnt : 1u;
}
DI void xcd_barrier(const XcdBarrier& b) {
  asm volatile("s_waitcnt vmcnt(0)" ::: "memory");
  __syncthreads();
  if (threadIdx.x == 0) {
    unsigned* bar = b.bar;
    __builtin_amdgcn_s_waitcnt(0);
    unsigned nloc = b.st[0], nx = b.st[1];
    if (nloc == 0u) { xcd_barrier_complete(bar, b.x, nloc, nx); b.st[0] = nloc; b.st[1] = nx; }
    const unsigned old = xb_add(&bar[XB_XSUB(b.x)], 1u);
    const unsigned gen = old / nloc;
    if (old + 1u == (gen + 1u) * nloc) {
      __builtin_amdgcn_fence(__ATOMIC_RELEASE, "agent");
      asm volatile("s_waitcnt vmcnt(0)" ::: "memory");
      const unsigned og = xb_add(&bar[XB_TOP], 1u);
      const unsigned tg = og / nx;
      if (og + 1u == (tg + 1u) * nx) xb_add(&bar[XB_TOPGEN], 1u);
      else XB_SPIN(xb_ld(&bar[XB_TOPGEN]) == tg, bar);
      __builtin_amdgcn_fence(__ATOMIC_ACQUIRE, "agent");
      xb_add(&bar[XB_XGEN(b.x)], 1u);
      asm volatile("s_waitcnt vmcnt(0)" ::: "memory");
    } else {
      XB_SPIN(xb_ld(&bar[XB_XGEN(b.x)]) == gen, bar);
      __builtin_amdgcn_fence(__ATOMIC_ACQUIRE, "agent");
      asm volatile("s_waitcnt vmcnt(0)" ::: "memory");
    }
  }
  __syncthreads();
}

DI void mod_item(const Params& p, int it, char* smem) {
  const int tid = otid();
  float* sv = (float*)smem;
  float* red = sv + 5 * 1024;
  const int l = it / 144, j0 = (it % 144) * 64;
  __syncthreads();
  for (int i = tid; i < 5120; i += 256) {
    int v = i >> 10, k = i & 1023;
    float c = (v == 0) ? pin(p, I_CCTX)[k] : pin(p, I_C)[(v - 1) * 1024 + k];
    sv[i] = c / (1.f + expf(-c));
  }
  __syncthreads();
  const int c4 = tid & 15, kg = tid >> 4;
  float acc[5][4];
#pragma unroll
  for (int v = 0; v < 5; ++v)
#pragma unroll
    for (int i = 0; i < 4; ++i) acc[v][i] = 0.f;
  const float* w = pin(p, I_WADA) + (size_t)l * 1024 * NMOD + j0 + c4 * 4;
#pragma unroll 1
  for (int k0 = kg; k0 < 1024; k0 += 128) {
    float4 wv[8];
#pragma unroll
    for (int u = 0; u < 8; ++u) wv[u] = *(const float4*)(w + (size_t)(k0 + 16 * u) * NMOD);
#pragma unroll
    for (int u = 0; u < 8; ++u)
#pragma unroll
      for (int v = 0; v < 5; ++v) {
        float s = sv[v * 1024 + k0 + 16 * u];
        acc[v][0] += s * wv[u].x; acc[v][1] += s * wv[u].y; acc[v][2] += s * wv[u].z; acc[v][3] += s * wv[u].w;
      }
  }
#pragma unroll
  for (int v = 0; v < 5; ++v)
#pragma unroll
    for (int i = 0; i < 4; ++i) red[(kg * 5 + v) * 64 + c4 * 4 + i] = acc[v][i];
  __syncthreads();
  for (int o = tid; o < 320; o += 256) {
    int v = o >> 6, c = o & 63;
    float s = 0.f;
    for (int k = 0; k < 16; ++k) s += red[(k * 5 + v) * 64 + c];
    s += pin(p, I_BADA)[l * NMOD + j0 + c];
    ((float*)(pws(p, OFF_MOD)))[(size_t)(l * 5 + v) * NMOD + j0 + c] = s;
  }
}

DI void filt_item(const Params& p, int it, char* smem) {
  const int tid = otid(), q = tid >> 6, tl = tid & 63;
  float* w1s = (float*)smem;
  float* w2s = w1s + 33 * 64;
  float* feats = w2s + 64 * 64;
  float* z1 = feats + 8 * 36;
  float* z2 = z1 + 8 * 64;
  const int l = it / 160, rem = it % 160;
  const float* w1 = pin(p, I_FW1) + l * 33 * 64;
  const float* b1 = pin(p, I_FB1) + l * 64;
  const float* w2 = pin(p, I_FW2) + l * 64 * 64;
  const float* b2 = pin(p, I_FB2) + l * 64;
  const float* w3 = pin(p, I_FW3) + l * 64 * 256;
  const float* b3 = pin(p, I_FB3) + l * 256;
  const float frq = pin(p, I_FFR)[l * 64 + tl];
  float* filt = (float*)(pws(p, OFF_FILT)) + (size_t)l * 1280 * 256;
  __syncthreads();
  for (int i = tid; i < 33 * 64; i += 256) w1s[i] = w1[i];
  for (int i = tid; i < 64 * 64; i += 256) w2s[i] = w2[i];
  int pidx[2], Lp[2], pos[2];
#pragma unroll
  for (int u = 0; u < 2; ++u) {
    pidx[u] = rem * 8 + q + 4 * u;
    Lp[u] = pidx[u] < 256 ? 256 : 1024;
    pos[u] = pidx[u] < 256 ? pidx[u] : pidx[u] - 256;
    if (tl < 33) {
      float f;
      if (tl == 0) f = (float)pos[u] / (float)(Lp[u] - 1);
      else {
        int j = (tl - 1) & 15;
        float fj = 1e-4f + (float)j * ((15.0f - 1e-4f) / 15.0f);
        float ang = (6.283185307179586f / (float)Lp[u]) * (float)pos[u] * fj;
        f = (tl <= 16) ? cosf(ang) : -sinf(ang);
      }
      feats[(q + 4 * u) * 36 + tl] = f;
    }
  }
  __syncthreads();
  {
    float s0 = b1[tl], s1 = s0;
#pragma unroll 3
    for (int j = 0; j < 33; ++j) {
      float w = w1s[j * 64 + tl];
      s0 += feats[q * 36 + j] * w;
      s1 += feats[(q + 4) * 36 + j] * w;
    }
    z1[q * 64 + tl] = sinf(frq * s0);
    z1[(q + 4) * 64 + tl] = sinf(frq * s1);
  }
  __syncthreads();
  {
    float s0 = b2[tl], s1 = s0;
#pragma unroll 4
    for (int j = 0; j < 64; ++j) {
      float w = w2s[j * 64 + tl];
      s0 += z1[q * 64 + j] * w;
      s1 += z1[(q + 4) * 64 + j] * w;
    }
    z2[q * 64 + tl] = sinf(frq * s0);
    z2[(q + 4) * 64 + tl] = sinf(frq * s1);
  }
  __syncthreads();
  float dist[2];
#pragma unroll
  for (int u = 0; u < 2; ++u) {
    const int centre = Lp[u] / 2;
    dist[u] = fabsf((float)(pos[u] - centre)) / (float)centre;
  }
#pragma unroll 1
  for (int cc = 0; cc < 4; ++cc) {
    const int c = tl + 64 * cc;
    float s0 = b3[c], s1 = s0;
#pragma unroll 1
    for (int j0 = 0; j0 < 64; j0 += 16) {
      float w[16];
#pragma unroll
      for (int j = 0; j < 16; ++j) w[j] = w3[(j0 + j) * 256 + c];
#pragma unroll
      for (int j = 0; j < 16; ++j) {
        s0 += z2[q * 64 + j0 + j] * w[j];
        s1 += z2[(q + 4) * 64 + j0 + j] * w[j];
      }
    }
    const float a = -3.0701134573253944f, b = -15.350567286626972f;
    const float delta = fabsf(a + (float)c * ((b - a) / 255.0f));
    filt[(size_t)pidx[0] * 256 + c] = s0 * expf(-dist[0] * delta);
    filt[(size_t)pidx[1] * 256 + c] = s1 * expf(-dist[1] * delta);
  }
}

struct ConvT {
  const float* src;
  bf16_t* dst;
  int K, N, k0, n0, gu;
};
DI ConvT conv_decode(const Params& p, int l, int idx) {
  bf16_t* wt = (bf16_t*)(pws(p, OFF_WT));
  int t = idx, which, K, N, nNt, gu;
  size_t dsto;
  if (t < 704) { which = I_W1G; K = DM; N = DFF; nNt = 44; dsto = WT_GU1; gu = 1; }
  else if ((t -= 704) < 704) { which = I_W1U; K = DM; N = DFF; nNt = 44; dsto = WT_GU1; gu = 2; }
  else if ((t -= 704) < 704) { which = I_W1D; K = DFF; N = DM; nNt = 16; dsto = WT_D1; gu = 0; }
  else if ((t -= 704) < 720) { which = I_WIN; K = DM; N = NIN; nNt = 45; dsto = WT_IN; gu = 0; }
  else if ((t -= 720) < 256) { which = I_WOUT; K = DM; N = DM; nNt = 16; dsto = WT_OUT; gu = 0; }
  else if ((t -= 256) < 704) { which = I_W2G; K = DM; N = DFF; nNt = 44; dsto = WT_GU2; gu = 1; }
  else if ((t -= 704) < 704) { which = I_W2U; K = DM; N = DFF; nNt = 44; dsto = WT_GU2; gu = 2; }
  else { t -= 704; which = I_W2D; K = DFF; N = DM; nNt = 16; dsto = WT_D2; gu = 0; }
  ConvT c;
  c.src = pin(p, which) + (size_t)l * K * N;
  c.dst = wt + dsto;
  c.K = K; c.N = N; c.k0 = (t / nNt) * 64; c.n0 = (t % nNt) * 64; c.gu = gu;
  return c;
}
DI void conv_load(const ConvT& c, int tid, float4 v[4]) {
#pragma unroll
  for (int i = 0; i < 4; ++i) {
    int r = (tid >> 4) + 16 * i, c4 = (tid & 15) * 4;
    v[i] = make_float4(0.f, 0.f, 0.f, 0.f);
    if (c.n0 + c4 < c.N) v[i] = *(const float4*)(c.src + (size_t)(c.k0 + r) * c.N + c.n0 + c4);
  }
}
DI void convert_layer(const Params& p, int l, char* smem) {
  const int tid = otid();
  float* tile = (float*)smem;
  int idx = obid();
  if (idx >= 5200) return;
  ConvT cur = conv_decode(p, l, idx);
  float4 v[4];
  conv_load(cur, tid, v);
  while (true) {
    __syncthreads();
#pragma unroll
    for (int i = 0; i < 4; ++i) {
      int r = (tid >> 4) + 16 * i, c4 = (tid & 15) * 4;
      tile[r * 65 + c4 + 0] = v[i].x; tile[r * 65 + c4 + 1] = v[i].y; tile[r * 65 + c4 + 2] = v[i].z; tile[r * 65 + c4 + 3] = v[i].w;
    }
    const int nxt = idx + gridDim.x;
    ConvT nx = cur;
    if (nxt < 5200) {
      nx = conv_decode(p, l, nxt);
      conv_load(nx, tid, v);
    }
    __syncthreads();
    const int n = tid >> 2, kq = tid & 3;
    if (cur.n0 + n < cur.N) {
      int nn = cur.n0 + n;
      int drow = (cur.gu == 0) ? nn : ((nn >> 5) * 64 + (cur.gu - 1) * 32 + (nn & 31));
      unsigned pk[8];
#pragma unroll
      for (int i = 0; i < 8; ++i)
        pk[i] = pack2(tile[(kq * 16 + 2 * i) * 65 + n], tile[(kq * 16 + 2 * i + 1) * 65 + n]);
      uint4* d = (uint4*)(cur.dst + (size_t)drow * cur.K + cur.k0 + kq * 16);
      d[0] = make_uint4(pk[0], pk[1], pk[2], pk[3]);
      d[1] = make_uint4(pk[4], pk[5], pk[6], pk[7]);
    }
    if (nxt >= 5200) break;
    idx = nxt;
    cur = nx;
  }
}

DI void phase_prologue(const Params& p, char* smem) {
  const int nb = gridDim.x, b = obid(), tid = otid();
  for (int it = b; it < 288; it += nb) mod_item(p, it, smem);
  for (int it = nb - 1 - b; it < 320; it += nb) filt_item(p, it, smem);
  {
    float* cosT = (float*)(pws(p, OFF_ROPE));
    float* sinT = cosT + 32768;
    for (int i = b * 256 + tid; i < 32768; i += nb * 256) {
      int t = i >> 5, e = i & 31;
      float pos = (e < 16) ? (float)(t >> 6) : (float)(t & 63);
      float inv = powf(10000.0f, -(float)(e & 15) / 16.0f);
      float ang = pos * inv;
      cosT[i] = cosf(ang);
      sinT[i] = sinf(ang);
    }
  }
  convert_layer(p, 0, smem);
}

DI void phase_norm(const Params& p, int l, bool from_input, const float* g, int part_shift, int part_scale) {
  const int lane = otid() & 63, wid = otid() >> 6;
  const float* modl = (const float*)(pws(p, OFF_MOD)) + (size_t)l * 5 * NMOD;
  bf16_t* H = (bf16_t*)(pws(p, OFF_H));
  const float* X = (const float*)(pws(p, OFF_X));
  for (int row = obid() * 4 + wid; row < NTOK; row += gridDim.x * 4) {
    const float* xr = from_input ? (row < NCTX ? pin(p, I_XP) + (size_t)row * DM : pin(p, I_XS) + (size_t)(row - NCTX) * DM)
                                 : X + (size_t)row * DM;
    float4 v[4];
    float ss = 0.f;
#pragma unroll
    for (int i = 0; i < 4; ++i) {
      v[i] = ((const float4*)xr)[lane + 64 * i];
      ss += v[i].x * v[i].x + v[i].y * v[i].y + v[i].z * v[i].z + v[i].w * v[i].w;
    }
    ss = wave_sum(ss);
    const float r = rsqrtf(ss * (1.0f / DM) + EPS);
    const float* mrow = modl + (size_t)mod_index(row) * NMOD;
#pragma unroll
    for (int i = 0; i < 4; ++i) {
      int c = 4 * (lane + 64 * i);
      float4 gg = *(const float4*)(g + c);
      float4 sc = *(const float4*)(mrow + part_scale * 1024 + c);
      float4 sh = *(const float4*)(mrow + part_shift * 1024 + c);
      float o0 = v[i].x * r * gg.x * (1.f + sc.x) + sh.x;
      float o1 = v[i].y * r * gg.y * (1.f + sc.y) + sh.y;
      float o2 = v[i].z * r * gg.z * (1.f + sc.z) + sh.z;
      float o3 = v[i].w * r * gg.w * (1.f + sc.w) + sh.w;
      *(uint2*)(H + (size_t)row * DM + c) = make_uint2(pack2(o0, o1), pack2(o2, o3));
    }
  }
}

DI void phase_final_norm(const Params& p) {
  const int lane = otid() & 63, wid = otid() >> 6;
  const float* X = (const float*)(pws(p, OFF_X));
  const float* g = pin(p, I_GFIN);
  for (int row = obid() * 4 + wid; row < NTOK; row += gridDim.x * 4) {
    const float* xr = X + (size_t)row * DM;
    float4 v[4];
    float ss = 0.f;
#pragma unroll
    for (int i = 0; i < 4; ++i) {
      v[i] = ((const float4*)xr)[lane + 64 * i];
      ss += v[i].x * v[i].x + v[i].y * v[i].y + v[i].z * v[i].z + v[i].w * v[i].w;
    }
    ss = wave_sum(ss);
    const float r = rsqrtf(ss * (1.0f / DM) + EPS);
#pragma unroll
    for (int i = 0; i < 4; ++i) {
      int c = 4 * (lane + 64 * i);
      float4 gg = *(const float4*)(g + c);
      float4 o = make_float4(v[i].x * r * gg.x, v[i].y * r * gg.y, v[i].z * r * gg.z, v[i].w * r * gg.w);
      *(float4*)(pout(p) + O_Y + (size_t)row * DM + c) = o;
    }
  }
}

enum { EPI_GU = 0, EPI_RES = 1, EPI_U = 2 };
struct EpiArgs {
  void* out;
  const float* xin0;
  const float* xin1;
  const float* modp;
  float coef;
};

using f32x16 = __attribute__((ext_vector_type(16))) float;
#define MFMA32(a, b, c) __builtin_amdgcn_mfma_f32_32x32x16_bf16((a), (b), (c), 0, 0, 0)

template <int EPI>
DI void gemm_phase(const bf16_t* __restrict__ A, int lda, const bf16_t* __restrict__ Bt, int ldb, int M, int N, int K,
                   const EpiArgs ea, char* smem, int tile_lo = 0, int tile_hi = 1 << 30) {
  const int tid = otid(), lane = tid & 63, r32 = lane & 31, h = lane >> 5;
  const int wid = __builtin_amdgcn_readfirstlane(tid >> 6);
  const int wn = wid & 1, kh = wid >> 1;
  const int nM = M / 128, nN = (N + 127) / 128, ntiles = (nM * nN < tile_hi) ? nM * nN : tile_hi, nk = K / 32;
  const int lrow = tid >> 2;
  const int lkc = ((tid & 3) ^ ((tid >> 4) & 3)) * 8;
  const int fsw = ((kh * 2 + h) ^ ((r32 >> 2) & 3)) * 16;
  const int aoff = r32 * 64 + fsw;
  const int aoffk = aoff + kh * 4096, aoffg = aoff + (1 - kh) * 4096;
  const int boff = 8192 + (wn * 64 + r32) * 64 + fsw;
#define GEMM_ISSUE(kt_)                                                                                              \
  do {                                                                                                               \
    char* st_ = smem + ((kt_) & 3) * 16384 + wid * 1024;                                                             \
    const unsigned ko_ = (unsigned)(kt_) * 64u;                                                                      \
    __builtin_amdgcn_global_load_lds((const unsigned*)((const char*)A + (ao0 + ko_)), (unsigned*)(st_), 16, 0, 0);   \
    __builtin_amdgcn_global_load_lds((const unsigned*)((const char*)A + (ao1 + ko_)), (unsigned*)(st_ + 4096), 16, 0, 0); \
    __builtin_amdgcn_global_load_lds((const unsigned*)((const char*)Bt + (bo0 + ko_)), (unsigned*)(st_ + 8192), 16, 0, 0); \
    __builtin_amdgcn_global_load_lds((const unsigned*)((const char*)Bt + (bo1 + ko_)), (unsigned*)(st_ + 12288), 16, 0, 0); \
  } while (0)
#define GEMM_ADDR(tile_)                                                                                             \
  do {                                                                                                               \
    m0 = ((tile_) % nM) * 128;                                                                                       \
    n0 = ((tile_) / nM) * 128;                                                                                       \
    ao0 = (unsigned)((m0 + lrow) * lda + lkc) * 2u;                                                                  \
    ao1 = ao0 + (unsigned)(64 * lda) * 2u;                                                                           \
    int br0_ = n0 + lrow, br1_ = n0 + lrow + 64;                                                                     \
    br0_ = br0_ < N ? br0_ : N - 1;                                                                                  \
    br1_ = br1_ < N ? br1_ : N - 1;                                                                                  \
    bo0 = (unsigned)(br0_ * ldb + lkc) * 2u;                                                                         \
    bo1 = (unsigned)(br1_ * ldb + lkc) * 2u;                                                                         \
  } while (0)
  int tile = tile_lo + obid();
  int m0 = 0, n0 = 0;
  unsigned ao0 = 0, ao1 = 0, bo0 = 0, bo1 = 0;
  if (tile < ntiles) {
    GEMM_ADDR(tile);
    GEMM_ISSUE(0);
    GEMM_ISSUE(1);
    GEMM_ISSUE(2);
  }
  while (tile < ntiles) {
    f32x16 acc[4][2];
#pragma unroll
    for (int i = 0; i < 4; ++i)
#pragma unroll
      for (int j = 0; j < 2; ++j)
#pragma unroll
        for (int r = 0; r < 16; ++r) acc[i][j][r] = 0.f;
    for (int kt = 0; kt < nk; ++kt) {
      if (kt + 2 < nk) asm volatile("s_waitcnt vmcnt(8)" ::: "memory");
      else if (kt + 1 < nk) asm volatile("s_waitcnt vmcnt(4)" ::: "memory");
      else asm volatile("s_waitcnt vmcnt(0)" ::: "memory");
      asm volatile("s_waitcnt lgkmcnt(0)" ::: "memory");
      __builtin_amdgcn_s_barrier();
      if (kt + 3 < nk) GEMM_ISSUE(kt + 3);
      const char* st = smem + (kt & 3) * 16384;
      bf16x8 af[4], bfr[2];
#pragma unroll
      for (int i = 0; i < 4; ++i) af[i] = *(const bf16x8*)(st + ((i < 2) ? aoffk : aoffg) + (i & 1) * 2048);
#pragma unroll
      for (int j = 0; j < 2; ++j) bfr[j] = *(const bf16x8*)(st + boff + j * 2048);
#pragma unroll
      for (int i = 0; i < 4; ++i)
#pragma unroll
        for (int j = 0; j < 2; ++j) acc[i][j] = MFMA32(af[i], bfr[j], acc[i][j]);
    }
    asm volatile("s_waitcnt lgkmcnt(0)" ::: "memory");
    __builtin_amdgcn_s_barrier();
    {
      float* mine = (float*)(smem + wid * 16384);
      const float* theirs = (const float*)(smem + (wid ^ 2) * 16384);
#pragma unroll
      for (int i = 0; i < 2; ++i)
#pragma unroll
        for (int j = 0; j < 2; ++j)
#pragma unroll
          for (int r = 0; r < 16; ++r) mine[((i * 2 + j) * 16 + r) * 64 + lane] = acc[2 + i][j][r];
      __syncthreads();
#pragma unroll
      for (int i = 0; i < 2; ++i)
#pragma unroll
        for (int j = 0; j < 2; ++j) {
#pragma unroll
          for (int r = 0; r < 16; ++r) acc[i][j][r] += theirs[((i * 2 + j) * 16 + r) * 64 + lane];
          asm volatile("" ::: "memory");
        }
      asm volatile("s_waitcnt lgkmcnt(0)" ::: "memory");
      __builtin_amdgcn_s_barrier();
    }
    const int em0 = m0, en0 = n0;
    tile += gridDim.x;
    if (tile < ntiles) {
      GEMM_ADDR(tile);
      GEMM_ISSUE(0);
      GEMM_ISSUE(1);
      GEMM_ISSUE(2);
    }
    const int rbase = em0 + 2 * kh * 32 + 4 * h;
    if (EPI == EPI_GU) {
      bf16_t* act = (bf16_t*)ea.out + (size_t)rbase * DFF + ((en0 + wn * 64) >> 1) + r32;
#pragma unroll
      for (int mi = 0; mi < 2; ++mi)
#pragma unroll
        for (int rq = 0; rq < 4; ++rq) {
#pragma unroll
          for (int rr = 0; rr < 4; ++rr) {
            const int r = rq * 4 + rr;
            const float gt = acc[mi][0][r], up = acc[mi][1][r];
            act[(size_t)(mi * 32 + rr + 8 * rq) * DFF] = f2bf(gt / (1.f + __expf(-gt)) * up);
          }
          asm volatile("" ::: "memory");
        }
    } else if (EPI == EPI_RES) {
      float* X = (float*)ea.out + (size_t)rbase * DM + en0 + wn * 64 + r32;
      const float* xr = (em0 < NCTX ? ea.xin0 + (size_t)rbase * DM : ea.xin1 + (size_t)(rbase - NCTX) * DM) + en0 + wn * 64 + r32;
      const float* mr = ea.modp + (size_t)mod_index(em0) * NMOD + en0 + wn * 64 + r32;
      const float g0 = ea.coef * mr[0], g1 = ea.coef * mr[32];
#pragma unroll
      for (int mi = 0; mi < 2; ++mi)
#pragma unroll
        for (int rq = 0; rq < 4; ++rq) {
#pragma unroll
          for (int rr = 0; rr < 4; ++rr) {
            const int r = rq * 4 + rr;
            const size_t ro = (size_t)(mi * 32 + rr + 8 * rq) * DM;
            const float x0 = xr[ro], x1 = xr[ro + 32];
            X[ro] = x0 + g0 * acc[mi][0][r];
            X[ro + 32] = x1 + g1 * acc[mi][1][r];
          }
          asm volatile("" ::: "memory");
        }
    } else {
      float* U = (float*)ea.out + (size_t)rbase * NIN + en0 + wn * 64 + r32;
      const bool ok0 = en0 + wn * 64 + r32 < N, ok1 = en0 + wn * 64 + 32 + r32 < N;
#pragma unroll
      for (int mi = 0; mi < 2; ++mi)
#pragma unroll
        for (int rq = 0; rq < 4; ++rq) {
#pragma unroll
          for (int rr = 0; rr < 4; ++rr) {
            const int r = rq * 4 + rr;
            const size_t ro = (size_t)(mi * 32 + rr + 8 * rq) * NIN;
            if (ok0) U[ro] = acc[mi][0][r];
            if (ok1) U[ro + 32] = acc[mi][1][r];
          }
          asm volatile("" ::: "memory");
        }
    }
    asm volatile("s_waitcnt vmcnt(0)" ::: "memory");
  }
#undef GEMM_ISSUE
#undef GEMM_ADDR
}

template <int EPI>
DI void gemm_k64(const bf16_t* __restrict__ A, int lda, const bf16_t* __restrict__ Bt, int ldb, int M, int N, int K,
                   const EpiArgs ea, char* smem, int tile_lo = 0, int tile_hi = 1 << 30) {
  const int tid = otid(), lane = tid & 63, r32 = lane & 31, h = lane >> 5;
  const int wid = __builtin_amdgcn_readfirstlane(tid >> 6);
  const int wn = wid & 1, kh = wid >> 1;
  const int nM = M / 128, nN = (N + 127) / 128, ntiles = (nM * nN < tile_hi) ? nM * nN : tile_hi, nk = K / 64;
  const int lrow = tid >> 3;
  const int lkc = ((tid & 7) ^ ((tid >> 4) & 7)) * 8;
  const int fsw0 = ((kh * 4 + h) ^ ((r32 >> 1) & 7)) * 16, fsw1 = ((kh * 4 + 2 + h) ^ ((r32 >> 1) & 7)) * 16;
  const int aoffk = r32 * 128 + kh * 8192, aoffg = r32 * 128 + (1 - kh) * 8192;
  const int boff = 16384 + (wn * 64 + r32) * 128;
#define GEMM_ISSUE(kt_)                                                                                              \
  do {                                                                                                               \
    char* st_ = smem + ((kt_) & 1) * 32768 + wid * 1024;                                                             \
    const unsigned ko_ = (unsigned)(kt_) * 128u;                                                                     \
    _Pragma("unroll") for (int i_ = 0; i_ < 4; ++i_)                                                                 \
      __builtin_amdgcn_global_load_lds((const unsigned*)((const char*)A + (ao0 + i_ * ao32 + ko_)),                  \
                                       (unsigned*)(st_ + i_ * 4096), 16, 0, 0);                                      \
    _Pragma("unroll") for (int i_ = 0; i_ < 4; ++i_)                                                                 \
      __builtin_amdgcn_global_load_lds((const unsigned*)((const char*)Bt + (bo[i_] + ko_)),                          \
                                       (unsigned*)(st_ + 16384 + i_ * 4096), 16, 0, 0);                              \
  } while (0)
#define GEMM_ADDR(tile_)                                                                                             \
  do {                                                                                                               \
    m0 = ((tile_) % nM) * 128;                                                                                       \
    n0 = ((tile_) / nM) * 128;                                                                                       \
    ao0 = (unsigned)((m0 + lrow) * lda + lkc) * 2u;                                                                  \
    _Pragma("unroll") for (int i_ = 0; i_ < 4; ++i_) {                                                               \
      int br_ = n0 + lrow + 32 * i_;                                                                                 \
      br_ = br_ < N ? br_ : N - 1;                                                                                   \
      bo[i_] = (unsigned)(br_ * ldb + lkc) * 2u;                                                                     \
    }                                                                                                                \
  } while (0)
  const unsigned ao32 = (unsigned)(32 * lda) * 2u;
  int tile = tile_lo + obid();
  int m0 = 0, n0 = 0;
  unsigned ao0 = 0, bo[4] = {0, 0, 0, 0};
  if (tile < ntiles) {
    GEMM_ADDR(tile);
    GEMM_ISSUE(0);
  }
  while (tile < ntiles) {
    f32x16 acc[4][2];
#pragma unroll
    for (int i = 0; i < 4; ++i)
#pragma unroll
      for (int j = 0; j < 2; ++j)
#pragma unroll
        for (int r = 0; r < 16; ++r) acc[i][j][r] = 0.f;
    for (int kt = 0; kt < nk; ++kt) {
      asm volatile("s_waitcnt vmcnt(0)" ::: "memory");
      asm volatile("s_waitcnt lgkmcnt(0)" ::: "memory");
      __builtin_amdgcn_s_barrier();
      if (kt + 1 < nk) GEMM_ISSUE(kt + 1);
      const char* st = smem + (kt & 1) * 32768;
#pragma unroll
      for (int ks = 0; ks < 2; ++ks) {
        const int fsw = ks ? fsw1 : fsw0;
        bf16x8 af[4], bfr[2];
#pragma unroll
        for (int i = 0; i < 4; ++i) af[i] = *(const bf16x8*)(st + ((i < 2) ? aoffk : aoffg) + (i & 1) * 4096 + fsw);
#pragma unroll
        for (int j = 0; j < 2; ++j) bfr[j] = *(const bf16x8*)(st + boff + j * 4096 + fsw);
#pragma unroll
        for (int i = 0; i < 4; ++i)
#pragma unroll
          for (int j = 0; j < 2; ++j) acc[i][j] = MFMA32(af[i], bfr[j], acc[i][j]);
      }
    }
    asm volatile("s_waitcnt lgkmcnt(0)" ::: "memory");
    __builtin_amdgcn_s_barrier();
    {
      float* mine = (float*)(smem + wid * 16384);
      const float* theirs = (const float*)(smem + (wid ^ 2) * 16384);
#pragma unroll
      for (int i = 0; i < 2; ++i)
#pragma unroll
        for (int j = 0; j < 2; ++j)
#pragma unroll
          for (int r = 0; r < 16; ++r) mine[((i * 2 + j) * 16 + r) * 64 + lane] = acc[2 + i][j][r];
      __syncthreads();
#pragma unroll
      for (int i = 0; i < 2; ++i)
#pragma unroll
        for (int j = 0; j < 2; ++j) {
#pragma unroll
          for (int r = 0; r < 16; ++r) acc[i][j][r] += theirs[((i * 2 + j) * 16 + r) * 64 + lane];
          asm volatile("" ::: "memory");
        }
      asm volatile("s_waitcnt lgkmcnt(0)" ::: "memory");
      __builtin_amdgcn_s_barrier();
    }
    const int em0 = m0, en0 = n0;
    tile += gridDim.x;
    if (tile < ntiles) {
      GEMM_ADDR(tile);
      GEMM_ISSUE(0);
    }
    const int rbase = em0 + 2 * kh * 32 + 4 * h;
    if (EPI == EPI_GU) {
      bf16_t* act = (bf16_t*)ea.out + (size_t)rbase * DFF + ((en0 + wn * 64) >> 1) + r32;
#pragma unroll
      for (int mi = 0; mi < 2; ++mi)
#pragma unroll
        for (int rq = 0; rq < 4; ++rq) {
#pragma unroll
          for (int rr = 0; rr < 4; ++rr) {
            const int r = rq * 4 + rr;
            const float gt = acc[mi][0][r], up = acc[mi][1][r];
            act[(size_t)(mi * 32 + rr + 8 * rq) * DFF] = f2bf(gt / (1.f + __expf(-gt)) * up);
          }
          asm volatile("" ::: "memory");
        }
    } else if (EPI == EPI_RES) {
      float* X = (float*)ea.out + (size_t)rbase * DM + en0 + wn * 64 + r32;
      const float* xr = (em0 < NCTX ? ea.xin0 + (size_t)rbase * DM : ea.xin1 + (size_t)(rbase - NCTX) * DM) + en0 + wn * 64 + r32;
      const float* mr = ea.modp + (size_t)mod_index(em0) * NMOD + en0 + wn * 64 + r32;
      const float g0 = ea.coef * mr[0], g1 = ea.coef * mr[32];
      float xv[2][16][2];
#pragma unroll
      for (int mi = 0; mi < 2; ++mi)
#pragma unroll
        for (int r = 0; r < 16; ++r) {
          const size_t ro = (size_t)(mi * 32 + (r & 3) + 8 * (r >> 2)) * DM;
          xv[mi][r][0] = xr[ro];
          xv[mi][r][1] = xr[ro + 32];
        }
#pragma unroll
      for (int mi = 0; mi < 2; ++mi)
#pragma unroll
        for (int r = 0; r < 16; ++r) {
          const size_t ro = (size_t)(mi * 32 + (r & 3) + 8 * (r >> 2)) * DM;
          X[ro] = xv[mi][r][0] + g0 * acc[mi][0][r];
          X[ro + 32] = xv[mi][r][1] + g1 * acc[mi][1][r];
        }
    } else {
      float* U = (float*)ea.out + (size_t)rbase * NIN + en0 + wn * 64 + r32;
      const bool ok0 = en0 + wn * 64 + r32 < N, ok1 = en0 + wn * 64 + 32 + r32 < N;
#pragma unroll
      for (int mi = 0; mi < 2; ++mi)
#pragma unroll
        for (int rq = 0; rq < 4; ++rq) {
#pragma unroll
          for (int rr = 0; rr < 4; ++rr) {
            const int r = rq * 4 + rr;
            const size_t ro = (size_t)(mi * 32 + rr + 8 * rq) * NIN;
            if (ok0) U[ro] = acc[mi][0][r];
            if (ok1) U[ro + 32] = acc[mi][1][r];
          }
          asm volatile("" ::: "memory");
        }
    }
    asm volatile("s_waitcnt vmcnt(0)" ::: "memory");
  }
#undef GEMM_ISSUE
#undef GEMM_ADDR
}

template <int EPI>
DI void gemm_big(const bf16_t* __restrict__ A, int lda, const bf16_t* __restrict__ Bt, int ldb, int M, int N, int K,
                 const EpiArgs ea, char* smem, int tile_hi = 1 << 30) {
  const int tid = otid(), lane = tid & 63, r32 = lane & 31, h = lane >> 5;
  const int wid = __builtin_amdgcn_readfirstlane(tid >> 6);
  const int wm = wid >> 1, wn = wid & 1;
  const int nM = M / 256, nN = N / 128, ntiles = (nM * nN < tile_hi) ? nM * nN : tile_hi, nk = K / 32;
  const int lrow = tid >> 2;
  const int lkc = ((tid & 3) ^ ((tid >> 4) & 3)) * 8;
  const int sw0 = ((0 + h) ^ ((r32 >> 2) & 3)) * 16, sw1 = ((2 + h) ^ ((r32 >> 2) & 3)) * 16;
  const int arow = (wm * 128 + r32) * 64;
  const int brow = 16384 + (wn * 64 + r32) * 64;
#define BIG_ISSUE(kt_, st_i)                                                                                         \
  do {                                                                                                               \
    char* st_ = smem + (st_i) * 24576 + wid * 1024;                                                                  \
    const unsigned ko_ = (unsigned)(kt_) * 64u;                                                                      \
    __builtin_amdgcn_global_load_lds((const unsigned*)((const char*)A + (ao0 + ko_)), (unsigned*)(st_), 16, 0, 0);   \
    __builtin_amdgcn_global_load_lds((const unsigned*)((const char*)A + (ao0 + ao64 + ko_)), (unsigned*)(st_ + 4096), 16, 0, 0); \
    __builtin_amdgcn_global_load_lds((const unsigned*)((const char*)A + (ao0 + 2 * ao64 + ko_)), (unsigned*)(st_ + 8192), 16, 0, 0); \
    __builtin_amdgcn_global_load_lds((const unsigned*)((const char*)A + (ao0 + 3 * ao64 + ko_)), (unsigned*)(st_ + 12288), 16, 0, 0); \
    __builtin_amdgcn_global_load_lds((const unsigned*)((const char*)Bt + (bo0 + ko_)), (unsigned*)(st_ + 16384), 16, 0, 0); \
    __builtin_amdgcn_global_load_lds((const unsigned*)((const char*)Bt + (bo0 + bo64 + ko_)), (unsigned*)(st_ + 20480), 16, 0, 0); \
  } while (0)
#define BIG_ADDR(tile_)                                                                                              \
  do {                                                                                                               \
    m0 = ((tile_) % nM) * 256;                                                                                       \
    n0 = ((tile_) / nM) * 128;                                                                                       \
    ao0 = (unsigned)((m0 + lrow) * lda + lkc) * 2u;                                                                  \
    bo0 = (unsigned)((n0 + lrow) * ldb + lkc) * 2u;                                                                  \
  } while (0)
  const unsigned ao64 = (unsigned)(64 * lda) * 2u, bo64 = (unsigned)(64 * ldb) * 2u;
  int tile = obid();
  int m0 = 0, n0 = 0;
  unsigned ao0 = 0, bo0 = 0;
  if (tile < ntiles) {
    BIG_ADDR(tile);
    BIG_ISSUE(0, 0);
    BIG_ISSUE(1, 1);
  }
  while (tile < ntiles) {
    f32x16 acc[4][2];
#pragma unroll
    for (int i = 0; i < 4; ++i)
#pragma unroll
      for (int j = 0; j < 2; ++j)
#pragma unroll
        for (int r = 0; r < 16; ++r) acc[i][j][r] = 0.f;
    int sc = 0;
    for (int kt = 0; kt < nk; ++kt) {
      if (kt + 1 < nk) asm volatile("s_waitcnt vmcnt(6)" ::: "memory");
      else asm volatile("s_waitcnt vmcnt(0)" ::: "memory");
      asm volatile("s_waitcnt lgkmcnt(0)" ::: "memory");
      __builtin_amdgcn_s_barrier();
      if (kt + 2 < nk) {
        const int sn = sc == 0 ? 2 : sc - 1;
        BIG_ISSUE(kt + 2, sn);
      }
      const char* st = smem + sc * 24576;
      {
        bf16x8 af[4], bfr[2];
#pragma unroll
        for (int i = 0; i < 4; ++i) af[i] = *(const bf16x8*)(st + arow + i * 2048 + sw0);
#pragma unroll
        for (int j = 0; j < 2; ++j) bfr[j] = *(const bf16x8*)(st + brow + j * 2048 + sw0);
#pragma unroll
        for (int i = 0; i < 4; ++i)
#pragma unroll
          for (int j = 0; j < 2; ++j) acc[i][j] = MFMA32(af[i], bfr[j], acc[i][j]);
      }
      {
        bf16x8 af[4], bfr[2];
#pragma unroll
        for (int i = 0; i < 4; ++i) af[i] = *(const bf16x8*)(st + arow + i * 2048 + sw1);
#pragma unroll
        for (int j = 0; j < 2; ++j) bfr[j] = *(const bf16x8*)(st + brow + j * 2048 + sw1);
#pragma unroll
        for (int i = 0; i < 4; ++i)
#pragma unroll
          for (int j = 0; j < 2; ++j) acc[i][j] = MFMA32(af[i], bfr[j], acc[i][j]);
      }
      sc = sc == 2 ? 0 : sc + 1;
    }
    asm volatile("s_waitcnt lgkmcnt(0)" ::: "memory");
    __builtin_amdgcn_s_barrier();
    const int em0 = m0, en0 = n0;
    tile += gridDim.x;
    if (tile < ntiles) {
      BIG_ADDR(tile);
      BIG_ISSUE(0, 0);
      BIG_ISSUE(1, 1);
    }
    const int rbase = em0 + wm * 128 + 4 * h;
    if (EPI == EPI_GU) {
      bf16_t* act = (bf16_t*)ea.out + (size_t)rbase * DFF + ((en0 + wn * 64) >> 1) + r32;
#pragma unroll
      for (int mt = 0; mt < 4; ++mt)
#pragma unroll
        for (int rq = 0; rq < 4; ++rq) {
#pragma unroll
          for (int rr = 0; rr < 4; ++rr) {
            const int r = rq * 4 + rr;
            const float gt = acc[mt][0][r], up = acc[mt][1][r];
            act[(size_t)(mt * 32 + rr + 8 * rq) * DFF] = f2bf(gt / (1.f + __expf(-gt)) * up);
          }
          asm volatile("" ::: "memory");
        }
    } else {
      float* X = (float*)ea.out + (size_t)rbase * DM + en0 + wn * 64 + r32;
      const float* xr = (em0 < NCTX ? ea.xin0 + (size_t)rbase * DM : ea.xin1 + (size_t)(rbase - NCTX) * DM) + en0 + wn * 64 + r32;
      const float* mr = ea.modp + (size_t)mod_index(em0) * NMOD + en0 + wn * 64 + r32;
      const float g0 = ea.coef * mr[0], g1 = ea.coef * mr[32];
#pragma unroll
      for (int mt = 0; mt < 4; ++mt)
#pragma unroll
        for (int rq = 0; rq < 4; ++rq) {
#pragma unroll
          for (int rr = 0; rr < 4; ++rr) {
            const int r = rq * 4 + rr;
            const size_t ro = (size_t)(mt * 32 + rr + 8 * rq) * DM;
            const float x0 = xr[ro], x1 = xr[ro + 32];
            X[ro] = x0 + g0 * acc[mt][0][r];
            X[ro + 32] = x1 + g1 * acc[mt][1][r];
          }
          asm volatile("" ::: "memory");
        }
    }
    asm volatile("s_waitcnt vmcnt(0)" ::: "memory");
  }
#undef BIG_ISSUE
#undef BIG_ADDR
}

DI int key_row(int t) { return t < NCTX ? t : NCTX + ((t - NCTX) >> 10) * 1280 + 256 + ((t - NCTX) & 1023); }

DI void phase_prep(const Params& p, int l) {
  const int tid = otid();
  const float* U = (const float*)(pws(p, OFF_U));
  bf16_t* QB = (bf16_t*)(pws(p, OFF_QB));
  bf16_t* QC = (bf16_t*)(pws(p, OFF_QC));
  bf16_t* KB = (bf16_t*)(pws(p, OFF_KB));
  bf16_t* VB = (bf16_t*)(pws(p, OFF_VB));
  bf16_t* KC = (bf16_t*)(pws(p, OFF_KC));
  bf16_t* VC = (bf16_t*)(pws(p, OFF_VC));
  const float* cosT = (const float*)(pws(p, OFF_ROPE));
  const float* sinT = cosT + 32768;
  const float* gq = pin(p, I_GQN) + l * 64;
  const float* gk = pin(p, I_GKN) + l * 64;
  const int gid = (obid() * 256 + tid) >> 4, ngroups = gridDim.x * 16, i16 = tid & 15;
  const int nunits = NTOK * 16;
#pragma unroll 4
  for (int base = 0; base < nunits; base += ngroups) {
    int unit = base + gid;
    const bool valid = unit < nunits;
    if (!valid) unit = nunits - 1;
    const int t = unit >> 4, hv = unit & 15;
    int col;
    if (hv < 4) col = 1040 + hv * 64;
    else if (hv < 6) col = 1296 + (hv - 4) * 64;
    else if (hv < 8) col = 1424 + (hv - 6) * 64;
    else if (hv < 12) col = 1552 + (hv - 8) * 64;
    else if (hv < 14) col = 1808 + (hv - 12) * 64;
    else col = 1936 + (hv - 14) * 64;
    float4 xv = *(const float4*)(U + (size_t)t * NIN + col + i16 * 4);
    float x[4] = {xv.x, xv.y, xv.z, xv.w};
    const bool lat = t >= NCTX;
    const bool do_norm = hv < 6;
    const bool is_q = (hv < 4) || (hv >= 8 && hv < 12);
    const bool is_v = (hv == 6 || hv == 7 || hv >= 14);
    float ss = x[0] * x[0] + x[1] * x[1] + x[2] * x[2] + x[3] * x[3];
    ss += shx<1>(ss); ss += shx<2>(ss); ss += shx<4>(ss); ss += shx<8>(ss);
    if (do_norm) {
      const float r = rsqrtf(ss * (1.0f / 64.0f) + EPS);
      const float* gg = (hv < 4) ? gq : gk;
#pragma unroll
      for (int j = 0; j < 4; ++j) x[j] = x[j] * r * gg[i16 * 4 + j];
    }
    if (!lat && valid && !is_q) {
      const int b = t >> 8, s = t & 255;
      size_t o;
      int kvh;
      if (hv < 6) { o = O_GK; kvh = hv - 4; }
      else if (hv < 8) { o = O_GV; kvh = hv - 6; }
      else if (hv < 14) { o = O_SK; kvh = hv - 12; }
      else { o = O_SV; kvh = hv - 14; }
      float* dst = pout(p) + o + ((size_t)((b * 2 + l) * 256 + s)) * 128 + kvh * 64 + i16 * 4;
      *(float4*)dst = make_float4(x[0], x[1], x[2], x[3]);
    }
    float xp[4];
#pragma unroll
    for (int j = 0; j < 4; ++j) xp[j] = shx<4>(x[j]);
    if (lat && !is_v) {
      const int s = (t - NCTX) & 1023;
      const bool first = (i16 & 4) == 0;
#pragma unroll
      for (int j = 0; j < 4; ++j) {
        int d = i16 * 4 + j;
        int e = (d < 32) ? (d & 15) : 16 + (d & 15);
        float cs = cosT[s * 32 + e], sn = sinT[s * 32 + e];
        x[j] = first ? (x[j] * cs - xp[j] * sn) : (x[j] * cs + xp[j] * sn);
      }
    }
    if (is_q) {
#pragma unroll
      for (int j = 0; j < 4; ++j) x[j] *= 0.125f;
    }
    if (valid) {
      uint2 pk = make_uint2(pack2(x[0], x[1]), pack2(x[2], x[3]));
      bf16_t* dst;
      if (hv < 4) dst = QB + (size_t)t * 256 + hv * 64;
      else if (hv < 6) dst = KB + (size_t)key_row(t) * 128 + (hv - 4) * 64;
      else if (hv < 8) dst = VB + (size_t)key_row(t) * 128 + (hv - 6) * 64;
      else if (hv < 12) dst = QC + (size_t)t * 256 + (hv - 8) * 64;
      else if (hv < 14) dst = KC + (size_t)key_row(t) * 128 + (hv - 12) * 64;
      else dst = VC + (size_t)key_row(t) * 128 + (hv - 14) * 64;
      *(uint2*)(dst + i16 * 4) = pk;
    }
  }
  for (int i = obid() * 256 + tid; i < 4 * 4 * 256 * 32; i += gridDim.x * 256) {
    const int which = i >> 15, rem = i & 32767;
    const int b = rem >> 13, s = (rem >> 5) & 255, c4 = (rem & 31) * 4;
    const float* srcb = (which == 0) ? pin(p, I_CGK) : (which == 1) ? pin(p, I_CGV) : (which == 2) ? pin(p, I_CSK) : pin(p, I_CSV);
    const float* src = srcb + ((size_t)((b * 2 + l) * 256 + s)) * 128 + c4;
    float4 v = *(const float4*)src;
    bf16_t* dstb = (which == 0) ? KB : (which == 1) ? VB : (which == 2) ? KC : VC;
    *(uint2*)(dstb + (size_t)(NCTX + b * 1280 + s) * 128 + c4) = make_uint2(pack2(v.x, v.y), pack2(v.z, v.w));
  }
}

DI void attn_item(const bf16_t* Q, const bf16_t* K, const bf16_t* V, int q0, int n1, int start2, int n2, bool window,
                  bool has_sink, float sink, bf16_t* Y, char* smem) {
  const int tid = otid(), lane = tid & 63, wid = tid >> 6, g = lane >> 4, r16 = lane & 15;
  bf16_t* Ks = (bf16_t*)smem;
  bf16_t* Vt = Ks + 64 * 72;
  int qrow[2];
  bf16x8 qf[2][2];
  float m_run[2], l_run[2];
  f32x4 o[2][4];
#pragma unroll
  for (int u = 0; u < 2; ++u) {
    qrow[u] = q0 + wid * 32 + u * 16 + r16;
    qf[u][0] = *(const bf16x8*)(Q + (size_t)qrow[u] * 256 + g * 8);
    qf[u][1] = *(const bf16x8*)(Q + (size_t)qrow[u] * 256 + 32 + g * 8);
    m_run[u] = has_sink ? sink : -INFINITY;
    l_run[u] = (has_sink && g == 0) ? 1.f : 0.f;
#pragma unroll
    for (int i = 0; i < 4; ++i) o[u][i] = (f32x4){0.f, 0.f, 0.f, 0.f};
  }
  const int ntl = n1 + n2;
  uint4 pk[2], pv[2];
#pragma unroll
  for (int j = 0; j < 2; ++j) {
    int c = tid + 256 * j, key = c >> 3, dc = (c & 7) * 8;
    const int tile0 = n1 > 0 ? 0 : start2;
    pk[j] = *(const uint4*)(K + (size_t)(tile0 * 64 + key) * 128 + dc);
    pv[j] = *(const uint4*)(V + (size_t)(tile0 * 64 + key) * 128 + dc);
  }
  for (int ti = 0; ti < ntl; ++ti) {
    const int tile = ti < n1 ? ti : start2 + (ti - n1);
    __syncthreads();
#pragma unroll
    for (int j = 0; j < 2; ++j) {
      int c = tid + 256 * j, key = c >> 3, dc = (c & 7) * 8;
      uint4 kv = pk[j];
      *(uint4*)(Ks + key * 72 + dc) = kv;
      uint4 vv = pv[j];
      unsigned w[4] = {vv.x, vv.y, vv.z, vv.w};
#pragma unroll
      for (int i = 0; i < 4; ++i) {
        Vt[(dc + 2 * i) * 72 + key] = (bf16_t)(w[i] & 0xffffu);
        Vt[(dc + 2 * i + 1) * 72 + key] = (bf16_t)(w[i] >> 16);
      }
    }
    __syncthreads();
    if (ti + 1 < ntl) {
      const int tnext = (ti + 1) < n1 ? (ti + 1) : start2 + (ti + 1 - n1);
#pragma unroll
      for (int j = 0; j < 2; ++j) {
        int c = tid + 256 * j, key = c >> 3, dc = (c & 7) * 8;
        pk[j] = *(const uint4*)(K + (size_t)(tnext * 64 + key) * 128 + dc);
        pv[j] = *(const uint4*)(V + (size_t)(tnext * 64 + key) * 128 + dc);
      }
    }
    f32x4 s[2][4];
#pragma unroll
    for (int kt = 0; kt < 4; ++kt) {
      bf16x8 a0 = *(const bf16x8*)(Ks + (kt * 16 + r16) * 72 + g * 8);
      bf16x8 a1 = *(const bf16x8*)(Ks + (kt * 16 + r16) * 72 + 32 + g * 8);
#pragma unroll
      for (int u = 0; u < 2; ++u) {
        f32x4 z = (f32x4){0.f, 0.f, 0.f, 0.f};
        z = MFMA16(a0, qf[u][0], z);
        s[u][kt] = MFMA16(a1, qf[u][1], z);
      }
    }
    bf16x8 pb[2][2];
#pragma unroll
    for (int u = 0; u < 2; ++u) {
      if (window && tile >= 4) {
#pragma unroll
        for (int kt = 0; kt < 4; ++kt)
#pragma unroll
          for (int j = 0; j < 4; ++j) {
            int kp = (tile - 4) * 64 + kt * 16 + g * 4 + j;
            int dlt = kp - qrow[u];
            if (dlt > 128 || dlt < -128) s[u][kt][j] = -INFINITY;
          }
      }
      float mx = -INFINITY;
#pragma unroll
      for (int kt = 0; kt < 4; ++kt)
#pragma unroll
        for (int j = 0; j < 4; ++j) mx = fmaxf(mx, s[u][kt][j]);
      mx = fmaxf(mx, shx<16>(mx));
      mx = fmaxf(mx, __shfl_xor(mx, 32));
      const float m_new = fmaxf(m_run[u], mx);
      float alpha, msub;
      if (m_new == -INFINITY) { alpha = 1.f; msub = 0.f; }
      else { alpha = __expf(m_run[u] - m_new); msub = m_new; }
      float lsum = 0.f;
#pragma unroll
      for (int kt = 0; kt < 4; ++kt)
#pragma unroll
        for (int j = 0; j < 4; ++j) {
          float pe = __expf(s[u][kt][j] - msub);
          s[u][kt][j] = pe;
          lsum += pe;
        }
      l_run[u] = l_run[u] * alpha + lsum;
      m_run[u] = m_new;
#pragma unroll
      for (int i = 0; i < 4; ++i) o[u][i] *= alpha;
#pragma unroll
      for (int c = 0; c < 2; ++c) {
        unsigned* pw = (unsigned*)&pb[u][c];
        pw[0] = pack2(s[u][2 * c][0], s[u][2 * c][1]);
        pw[1] = pack2(s[u][2 * c][2], s[u][2 * c][3]);
        pw[2] = pack2(s[u][2 * c + 1][0], s[u][2 * c + 1][1]);
        pw[3] = pack2(s[u][2 * c + 1][2], s[u][2 * c + 1][3]);
      }
    }
#pragma unroll
    for (int c = 0; c < 2; ++c)
#pragma unroll
      for (int et = 0; et < 4; ++et) {
        const bf16_t* vp = Vt + (et * 16 + r16) * 72 + c * 32 + g * 4;
        bf16x4 lo = *(const bf16x4*)(vp);
        bf16x4 hi = *(const bf16x4*)(vp + 16);
        bf16x8 a = __builtin_shufflevector(lo, hi, 0, 1, 2, 3, 4, 5, 6, 7);
#pragma unroll
        for (int u = 0; u < 2; ++u) o[u][et] = MFMA16(a, pb[u][c], o[u][et]);
      }
  }
#pragma unroll
  for (int u = 0; u < 2; ++u) {
    float lt = l_run[u];
    lt += shx<16>(lt);
    lt += __shfl_xor(lt, 32);
    const float inv = 1.f / lt;
#pragma unroll
    for (int et = 0; et < 4; ++et) {
      uint2 pk2 = make_uint2(pack2(o[u][et][0] * inv, o[u][et][1] * inv), pack2(o[u][et][2] * inv, o[u][et][3] * inv));
      *(uint2*)(Y + (size_t)qrow[u] * DM + et * 16 + g * 4) = pk2;
    }
  }
}

using f32x2 = __attribute__((ext_vector_type(2))) float;
template <int NI>
DI void hyena_item(const Params& p, int l, int tok0, int cq, bf16_t* YM, char* smem) {
  constexpr int L = NI * 256;
  constexpr int NH = (NI >= 2) ? NI / 2 : 1;
  const int tid = otid(), lane = tid & 63;
  const int wid = __builtin_amdgcn_readfirstlane(tid >> 6);
  const int pr = wid & 1, hf = wid >> 1;
  const int c0 = cq * 4, ca = c0 + 2 * pr;
  f32x2* zz = (f32x2*)((float*)smem + pr * (8 * L));
  f32x2* h2 = zz + 2 * L;
  f32x2* x2 = h2 + L;
  float* raw = (float*)smem + 2 * (8 * L);
  const float* U = (const float*)(pws(p, OFF_U));
  const float* cw = pin(p, I_CW) + l * 3 * 768;
  const float* cb = pin(p, I_CB) + l * 768;
  const float* filt = (const float*)(pws(p, OFF_FILT)) + (size_t)l * 1280 * 256 + (size_t)(NI == 1 ? 0 : 256) * 256;
  f32x2 w0a, w0b, w0c, b0, w1a, w1b, w1c, b1, w2a, w2b, w2c, b2;
#pragma unroll
  for (int e = 0; e < 2; ++e) {
    const int c = ca + e;
    w0a[e] = cw[c]; w0b[e] = cw[768 + c]; w0c[e] = cw[1536 + c]; b0[e] = cb[c];
    w1a[e] = cw[256 + c]; w1b[e] = cw[768 + 256 + c]; w1c[e] = cw[1536 + 256 + c]; b1[e] = cb[256 + c];
    w2a[e] = cw[512 + c]; w2b[e] = cw[768 + 512 + c]; w2c[e] = cw[1536 + 512 + c]; b2[e] = cb[512 + c];
  }
  __syncthreads();
  {
    const f32x2 zero = {0.f, 0.f};
    for (int i = lane + 64 * hf; i < L / 2; i += 128) { zz[i] = zero; zz[3 * L / 2 + i] = zero; }
  }
  for (int s = tid; s < L; s += 256) {
    const float4 f = *(const float4*)(filt + (size_t)s * 256 + c0);
    f32x2* hA = (f32x2*)((float*)smem) + 2 * L + s;
    f32x2* hB = (f32x2*)((float*)smem + 8 * L) + 2 * L + s;
    *hA = (f32x2){f.x, f.y};
    *hB = (f32x2){f.z, f.w};
  }
#pragma unroll 1
  for (int ch = 0; ch < NI; ++ch) {
    __syncthreads();
#pragma unroll
    for (int k = 0; k < 4; ++k) {
      const int idx = tid + 256 * k;
      if (idx < 774) {
        const int reg = idx / 258, row = idx - reg * 258;
        const int t = ch * 256 - 1 + row;
        float4 v = make_float4(0.f, 0.f, 0.f, 0.f);
        if (t >= 0 && t < L) v = *(const float4*)(U + (size_t)(tok0 + t) * NIN + 2064 + reg * 256 + c0);
        *(float4*)(raw + (size_t)idx * 4) = v;
      }
    }
    __syncthreads();
#pragma unroll
    for (int k = 0; k < 2; ++k) {
      const int tl = lane + 64 * k + 128 * hf, row = tl + 1;
      const f32x2* r0 = (const f32x2*)(raw + (0 * 258 + row) * 4 + 2 * pr);
      const f32x2* r1 = (const f32x2*)(raw + (1 * 258 + row) * 4 + 2 * pr);
      const f32x2* r2 = (const f32x2*)(raw + (2 * 258 + row) * 4 + 2 * pr);
      const f32x2 x0 = b0 + w0a * r0[-2] + w0b * r0[0] + w0c * r0[2];
      const f32x2 x1 = b1 + w1a * r1[-2] + w1b * r1[0] + w1c * r1[2];
      const f32x2 vv = b2 + w2a * r2[-2] + w2b * r2[0] + w2c * r2[2];
      const int t = ch * 256 + tl;
      zz[L / 2 + t] = x1 * vv;
      x2[t] = x0;
    }
  }
  __syncthreads();
  f32x2 acc[NH][4];
  float4 hi[NH][2];
  const float4* zz4 = (const float4*)__builtin_assume_aligned(zz, 16);
  const float4* h4p = (const float4*)__builtin_assume_aligned(h2, 16);
  const int gofs = (NI >= 2) ? NH * hf : 0;
#pragma unroll
  for (int i = 0; i < NH; ++i) {
#pragma unroll
    for (int j = 0; j < 4; ++j) acc[i][j] = (f32x2){0.f, 0.f};
    const int xb = 4 * lane + 256 * (gofs + i) + L;
    hi[i][0] = zz4[xb / 2];
    hi[i][1] = zz4[xb / 2 + 1];
  }
  const bool active = (NI >= 2) || (hf == 0);
  if (active) {
    float4 lo[NH][2], hq[2];
#pragma unroll
    for (int i = 0; i < NH; ++i) {
      const int xb = 4 * lane + 256 * (gofs + i) + L - 4;
      lo[i][0] = zz4[xb / 2];
      lo[i][1] = zz4[xb / 2 + 1];
    }
    hq[0] = h4p[0];
    hq[1] = h4p[1];
#pragma unroll 2
    for (int sg = 0; sg < L / 4; ++sg) {
      const int sn = (sg + 1 < L / 4) ? sg + 1 : sg;
      float4 nlo[NH][2], nhq[2];
#pragma unroll
      for (int i = 0; i < NH; ++i) {
        const int xb = 4 * lane + 256 * (gofs + i) + L - 4 * sn - 4;
        nlo[i][0] = zz4[xb / 2];
        nlo[i][1] = zz4[xb / 2 + 1];
      }
      nhq[0] = h4p[2 * sn];
      nhq[1] = h4p[2 * sn + 1];
      const f32x2 hh[4] = {(f32x2){hq[0].x, hq[0].y}, (f32x2){hq[0].z, hq[0].w}, (f32x2){hq[1].x, hq[1].y}, (f32x2){hq[1].z, hq[1].w}};
#pragma unroll
      for (int i = 0; i < NH; ++i) {
        const float4 lo0 = lo[i][0], lo1 = lo[i][1];
        const f32x2 w[8] = {(f32x2){lo0.x, lo0.y}, (f32x2){lo0.z, lo0.w}, (f32x2){lo1.x, lo1.y}, (f32x2){lo1.z, lo1.w},
                            (f32x2){hi[i][0].x, hi[i][0].y}, (f32x2){hi[i][0].z, hi[i][0].w},
                            (f32x2){hi[i][1].x, hi[i][1].y}, (f32x2){hi[i][1].z, hi[i][1].w}};
#pragma unroll
        for (int j = 0; j < 4; ++j) {
          f32x2 a = acc[i][j];
          a = __builtin_elementwise_fma(hh[0], w[4 + j], a);
          a = __builtin_elementwise_fma(hh[1], w[3 + j], a);
          a = __builtin_elementwise_fma(hh[2], w[2 + j], a);
          a = __builtin_elementwise_fma(hh[3], w[1 + j], a);
          acc[i][j] = a;
        }
        hi[i][0] = lo0;
        hi[i][1] = lo1;
        lo[i][0] = nlo[i][0];
        lo[i][1] = nlo[i][1];
      }
      hq[0] = nhq[0];
      hq[1] = nhq[1];
    }
  }
  f32x2 hb;
  hb[0] = pin(p, I_HBIAS)[l * 256 + ca];
  hb[1] = pin(p, I_HBIAS)[l * 256 + ca + 1];
  bf16_t* obuf = (bf16_t*)raw;
  if (active) {
#pragma unroll
    for (int i = 0; i < NH; ++i)
#pragma unroll
      for (int j = 0; j < 4; ++j) {
        const int t = 4 * lane + 256 * (gofs + i) + j;
        const f32x2 y = acc[i][j] + hb * zz[t + L / 2];
        const f32x2 o = x2[t] * y;
        *(unsigned*)(obuf + t * 4 + 2 * pr) = pack2(o[0], o[1]);
      }
  }
  __syncthreads();
  for (int t = tid; t < L; t += 256)
    *(uint2*)(YM + (size_t)(tok0 + t) * DM + 768 + c0) = *(const uint2*)(obuf + t * 4);
}

constexpr int FLAG_WORD0 = 3584;
DI void mlstm_dir_item(const Params& p, int l, bool lat, int bidx, int tok0, int L, int head, int dir, int* flag, char* smem) {
  const int tid = otid(), lane = tid & 63, g = lane >> 4, r16 = lane & 15;
  const int wid = __builtin_amdgcn_readfirstlane(tid >> 6);
  bf16_t* Qs = (bf16_t*)smem;
  bf16_t* Ks = Qs + 64 * 72;
  bf16_t* Vt = Ks + 64 * 72;
  bf16_t* Ct = Vt + 64 * 72;
  float* vec = (float*)(smem + 4 * 9216);
  float* v_d1 = vec + 320;
  float* S_bc = (float*)(smem + 4 * 9216 + 4096);
  float* S_amb = S_bc + 1024;
  float* S_mt = S_amb + 1024;
  float* S_wi = S_mt + 1024;
  float* S_wk = S_wi + 1024;
  float* S_btot = S_wk + 1024;
  float* S_mx = S_btot + 16;
  float* S_dec = S_mx + 16;
  float* S_mnew = S_dec + 16;
  float* v_d2 = vec + 384;
  float* v_np = vec + 640;
  float* v_n = vec + 896;
  float* v_sc = vec + 960;
  const float* U = (const float*)(pws(p, OFF_U));
  float* HD = (float*)(pws(p, dir == 0 ? OFF_HF : OFF_HB));
  const int nc = L / 64;
  const float gbi = pin(p, I_BG)[l * 16 + dir * 4 + head];
  const float gbf = pin(p, I_BG)[l * 16 + 8 + dir * 4 + head];
  const size_t sidx = ((size_t)((bidx * 2 + l) * 2 + dir)) * 4 + head;

  f32x4 cacc[4];
  __syncthreads();
  if (lat) {
    const float* sc = pin(p, I_SC) + sidx * 4096;
#pragma unroll
    for (int et = 0; et < 4; ++et)
#pragma unroll
      for (int j = 0; j < 4; ++j) cacc[et][j] = sc[(wid * 16 + g * 4 + j) * 64 + et * 16 + r16];
    if (tid < 64) v_n[tid] = pin(p, I_SN)[sidx * 64 + tid];
    if (tid == 0) v_sc[0] = pin(p, I_SM)[sidx];
  } else {
#pragma unroll
    for (int et = 0; et < 4; ++et) cacc[et] = (f32x4){0.f, 0.f, 0.f, 0.f};
    if (tid < 64) v_n[tid] = 0.f;
    if (tid == 0) v_sc[0] = 0.f;
  }
#pragma unroll
  for (int et = 0; et < 4; ++et)
    *(uint2*)(Ct + (et * 16 + r16) * 72 + wid * 16 + g * 4) =
        make_uint2(pack2(cacc[et][0], cacc[et][1]), pack2(cacc[et][2], cacc[et][3]));

  for (int c = wid; c < nc; c += 4) {
    const int pos = c * 64 + lane;
    const int tok = tok0 + (dir == 0 ? pos : L - 1 - pos);
    const float igv = U[(size_t)tok * NIN + 1024 + dir * 4 + head] + gbi;
    const float fgv = U[(size_t)tok * NIN + 1032 + dir * 4 + head] + gbf;
    const float lf = fminf(fgv, 0.f) - __logf(1.f + __expf(-fabsf(fgv)));
    float bc = lf;
#pragma unroll
    for (int o = 1; o < 64; o <<= 1) {
      float up = __shfl_up(bc, o);
      if (lane >= o) bc += up;
    }
    const float amb = igv - bc;
    float pm = amb;
#pragma unroll
    for (int o = 1; o < 64; o <<= 1) {
      float up = __shfl_up(pm, o);
      if (lane >= o) pm = fmaxf(pm, up);
    }
    const float btot = __shfl(bc, 63);
    const float wlog = btot - bc + igv;
    float mx = wlog;
    mx = fmaxf(mx, shx<32>(mx)); mx = fmaxf(mx, shx<16>(mx)); mx = fmaxf(mx, shx<8>(mx));
    mx = fmaxf(mx, shx<4>(mx)); mx = fmaxf(mx, shx<2>(mx)); mx = fmaxf(mx, shx<1>(mx));
    S_bc[c * 64 + lane] = bc;
    S_amb[c * 64 + lane] = amb;
    S_mt[c * 64 + lane] = bc + pm;
    S_wk[c * 64 + lane] = wlog;
    if (lane == 0) { S_btot[c] = btot; S_mx[c] = mx; }
  }
  __syncthreads();
  if (wid == 0) {
    float m_old = v_sc[0];
    for (int c = 0; c < nc; ++c) {
      const float bc = S_bc[c * 64 + lane];
      const float inter = bc + m_old;
      const float mt = fmaxf(S_mt[c * 64 + lane], inter);
      const float btot = S_btot[c];
      const float m_new = fmaxf(btot + m_old, S_mx[c]);
      S_mt[c * 64 + lane] = mt;
      S_wi[c * 64 + lane] = __expf(inter - mt);
      S_wk[c * 64 + lane] = __expf(S_wk[c * 64 + lane] - m_new);
      if (lane == 0) { S_dec[c] = __expf(btot + m_old - m_new); S_mnew[c] = m_new; }
      m_old = m_new;
    }
  }
  __syncthreads();
  float4 pq[4], pk4[4], pv4[4];
#define MLSTM_FETCH(ci_)                                                                                             \
  do {                                                                                                               \
    _Pragma("unroll") for (int j = 0; j < 4; ++j) {                                                                  \
      const int cidx = tid + 256 * j, row = cidx >> 4, d4 = (cidx & 15) * 4;                                         \
      const int pos = (ci_) * 64 + row;                                                                              \
      const int tok = tok0 + (dir == 0 ? pos : L - 1 - pos);                                                         \
      const float* ur = U + (size_t)tok * NIN + head * 64 + d4;                                                      \
      pq[j] = *(const float4*)(ur);                                                                                  \
      pk4[j] = *(const float4*)(ur + 256);                                                                           \
      pv4[j] = *(const float4*)(ur + 512);                                                                           \
    }                                                                                                                \
  } while (0)
  MLSTM_FETCH(0);
  for (int ci = 0; ci < nc; ++ci) {
#pragma unroll
    for (int j = 0; j < 4; ++j) {
      const int cidx = tid + 256 * j, row = cidx >> 4, d4 = (cidx & 15) * 4;
      const float4 qv = pq[j], kv = pk4[j], vv = pv4[j];
      *(uint2*)(Qs + row * 72 + d4) = make_uint2(pack2(qv.x, qv.y), pack2(qv.z, qv.w));
      *(uint2*)(Ks + row * 72 + d4) =
          make_uint2(pack2(kv.x * 0.125f, kv.y * 0.125f), pack2(kv.z * 0.125f, kv.w * 0.125f));
      Vt[(d4 + 0) * 72 + row] = f2bf(vv.x);
      Vt[(d4 + 1) * 72 + row] = f2bf(vv.y);
      Vt[(d4 + 2) * 72 + row] = f2bf(vv.z);
      Vt[(d4 + 3) * 72 + row] = f2bf(vv.w);
    }
    if (ci + 1 < nc) MLSTM_FETCH(ci + 1);
    const float* v_bc = S_bc + ci * 64;
    const float* v_amb = S_amb + ci * 64;
    const float* v_mt = S_mt + ci * 64;
    const float* v_wi = S_wi + ci * 64;
    const float* v_wk = S_wk + ci * 64;
    __syncthreads();
    f32x4 sp[4];
    unsigned n2k[4][2], spk[4][2];
    {
      bf16x8 qa[2];
#pragma unroll
      for (int ds = 0; ds < 2; ++ds) qa[ds] = *(const bf16x8*)(Qs + (wid * 16 + r16) * 72 + ds * 32 + g * 8);
#pragma unroll
      for (int st = 0; st < 4; ++st) {
        bf16x8 kb0 = *(const bf16x8*)(Ks + (st * 16 + r16) * 72 + g * 8);
        bf16x8 kb1 = *(const bf16x8*)(Ks + (st * 16 + r16) * 72 + 32 + g * 8);
        bf16x8 cb0 = *(const bf16x8*)(Ct + (st * 16 + r16) * 72 + g * 8);
        bf16x8 cb1 = *(const bf16x8*)(Ct + (st * 16 + r16) * 72 + 32 + g * 8);
        f32x4 z = (f32x4){0.f, 0.f, 0.f, 0.f};
        z = MFMA16(qa[0], kb0, z);
        sp[st] = MFMA16(qa[1], kb1, z);
        f32x4 y = (f32x4){0.f, 0.f, 0.f, 0.f};
        y = MFMA16(qa[0], cb0, y);
        y = MFMA16(qa[1], cb1, y);
        n2k[st][0] = pack2(y[0], y[1]);
        n2k[st][1] = pack2(y[2], y[3]);
      }
    }
    {
      float s = 0.f;
#pragma unroll
      for (int d = 0; d < 16; ++d) s += bf2f(Qs[lane * 72 + wid * 16 + d]) * v_n[wid * 16 + d];
      v_d2[wid * 64 + lane] = s;
    }
#pragma unroll
    for (int j = 0; j < 4; ++j) {
      const int t = wid * 16 + g * 4 + j;
      const float bt = v_bc[t] - v_mt[t];
      float rs = 0.f;
#pragma unroll
      for (int st = 0; st < 4; ++st) {
        const int s = st * 16 + r16;
        float wgt = (s <= t) ? __expf(bt + v_amb[s]) : 0.f;
        float val = sp[st][j] * wgt;
        sp[st][j] = val;
        rs += val;
      }
      rs += shx<1>(rs); rs += shx<2>(rs); rs += shx<4>(rs); rs += shx<8>(rs);
      if (r16 == 0) v_d1[t] = rs;
    }
#pragma unroll
    for (int st = 0; st < 4; ++st) {
      spk[st][0] = pack2(sp[st][0], sp[st][1]);
      spk[st][1] = pack2(sp[st][2], sp[st][3]);
    }
    __syncthreads();
    bf16_t* Sp = Qs;
    bf16_t* KwT = Ct;
#pragma unroll
    for (int st = 0; st < 4; ++st)
#pragma unroll
      for (int j = 0; j < 4; ++j)
        Sp[(wid * 16 + g * 4 + j) * 72 + st * 16 + r16] =
            (bf16_t)((j & 1) ? (spk[st][j >> 1] >> 16) : (spk[st][j >> 1] & 0xffffu));
    {
      const int s = tid & 63, dq = (tid >> 6) * 16;
      const float wk = v_wk[s];
#pragma unroll
      for (int d8 = 0; d8 < 2; ++d8) {
        bf16x8 kk = *(const bf16x8*)(Ks + s * 72 + dq + d8 * 8);
#pragma unroll
        for (int i = 0; i < 8; ++i) KwT[(dq + d8 * 8 + i) * 72 + s] = f2bf(bf2f((bf16_t)kk[i]) * wk);
      }
    }
    const float decay = S_dec[ci];
    {
      float s = 0.f;
#pragma unroll
      for (int q = 0; q < 16; ++q) s += v_wk[wid * 16 + q] * bf2f(Ks[(wid * 16 + q) * 72 + lane]);
      v_np[wid * 64 + lane] = s;
    }
    __syncthreads();
    if (wid == 0) v_n[lane] = decay * v_n[lane] + (v_np[lane] + v_np[64 + lane]) + (v_np[128 + lane] + v_np[192 + lane]);
    {
      bf16x8 sa[2], ka[2];
#pragma unroll
      for (int ks = 0; ks < 2; ++ks) {
        sa[ks] = *(const bf16x8*)(Sp + (wid * 16 + r16) * 72 + ks * 32 + g * 8);
        ka[ks] = *(const bf16x8*)(KwT + (wid * 16 + r16) * 72 + ks * 32 + g * 8);
      }
      float wi[4], dn[4];
      int tokr[4];
#pragma unroll
      for (int j = 0; j < 4; ++j) {
        const int t = wid * 16 + g * 4 + j;
        wi[j] = v_wi[t];
        float den = v_d1[t] + wi[j] * (v_d2[t] + v_d2[64 + t] + v_d2[128 + t] + v_d2[192 + t]);
        dn[j] = 1.f / fmaxf(fabsf(den), __expf(-v_mt[t]));
        const int pos = ci * 64 + t;
        tokr[j] = tok0 + (dir == 0 ? pos : L - 1 - pos);
      }
#pragma unroll
      for (int et = 0; et < 4; ++et) {
        bf16x8 vb0 = *(const bf16x8*)(Vt + (et * 16 + r16) * 72 + g * 8);
        bf16x8 vb1 = *(const bf16x8*)(Vt + (et * 16 + r16) * 72 + 32 + g * 8);
        f32x4 z = (f32x4){0.f, 0.f, 0.f, 0.f};
        z = MFMA16(sa[0], vb0, z);
        z = MFMA16(sa[1], vb1, z);
#pragma unroll
        for (int j = 0; j < 4; ++j) {
          float n2v = __uint_as_float((j & 1) ? (n2k[et][j >> 1] & 0xffff0000u) : (n2k[et][j >> 1] << 16));
          float hv = (z[j] + wi[j] * n2v) * dn[j];
          HD[(size_t)tokr[j] * 256 + head * 64 + et * 16 + r16] = hv;
        }
        f32x4 cc = cacc[et] * decay;
        cc = MFMA16(ka[0], vb0, cc);
        cacc[et] = MFMA16(ka[1], vb1, cc);
      }
    }
    __syncthreads();
#pragma unroll
    for (int et = 0; et < 4; ++et)
      *(uint2*)(Ct + (et * 16 + r16) * 72 + wid * 16 + g * 4) =
          make_uint2(pack2(cacc[et][0], cacc[et][1]), pack2(cacc[et][2], cacc[et][3]));
  }
#undef MLSTM_FETCH
  if (!lat) {
    float* oc = pout(p) + O_NC + sidx * 4096;
#pragma unroll
    for (int et = 0; et < 4; ++et)
#pragma unroll
      for (int j = 0; j < 4; ++j) oc[(wid * 16 + g * 4 + j) * 64 + et * 16 + r16] = cacc[et][j];
    if (wid == 0) pout(p)[O_NN + sidx * 64 + lane] = v_n[lane];
    if (tid == 0) pout(p)[O_NM + sidx] = S_mnew[nc - 1];
  }
  asm volatile("s_waitcnt vmcnt(0)" ::: "memory");
  __syncthreads();
  if (tid == 0) {
    __builtin_amdgcn_fence(__ATOMIC_RELEASE, "agent");
    asm volatile("s_waitcnt vmcnt(0)" ::: "memory");
    __hip_atomic_fetch_add(flag, 1, __ATOMIC_RELAXED, __HIP_MEMORY_SCOPE_AGENT);
  }
}

DI void mlstm_combine_item(const Params& p, int l, int tok0, int head, int* flag, bf16_t* YM) {
  const int tid = otid();
  if (tid == 0) {
    unsigned spins = 0;
    while (__hip_atomic_load(flag, __ATOMIC_RELAXED, __HIP_MEMORY_SCOPE_AGENT) < 2) {
      __builtin_amdgcn_s_sleep(2);
      if (++spins > (1u << 22)) break;
    }
    __builtin_amdgcn_fence(__ATOMIC_ACQUIRE, "agent");
    asm volatile("s_waitcnt vmcnt(0)" ::: "memory");
  }
  __syncthreads();
  const float* U = (const float*)(pws(p, OFF_U));
  const float* HF = (const float*)(pws(p, OFF_HF));
  const float* HB = (const float*)(pws(p, OFF_HB));
  const float* gm = pin(p, I_GML) + l * 256 + head * 64;
  const int i16 = tid & 15;
#pragma unroll 4
  for (int tt = tid >> 4; tt < 256; tt += 16) {
    const size_t tok = tok0 + tt;
    float4 a = *(const float4*)(HF + tok * 256 + head * 64 + i16 * 4);
    float4 b = *(const float4*)(HB + tok * 256 + head * 64 + i16 * 4);
    float h0 = a.x + b.x, h1 = a.y + b.y, h2 = a.z + b.z, h3 = a.w + b.w;
    float ss = h0 * h0 + h1 * h1 + h2 * h2 + h3 * h3;
    ss += shx<1>(ss); ss += shx<2>(ss); ss += shx<4>(ss); ss += shx<8>(ss);
    const float r = rsqrtf(ss * (1.0f / 64.0f) + EPS);
    float4 ov = *(const float4*)(U + tok * NIN + 768 + head * 64 + i16 * 4);
    float4 gg = *(const float4*)(gm + i16 * 4);
    float y0 = h0 * r * gg.x * sigmoidf_(ov.x);
    float y1 = h1 * r * gg.y * sigmoidf_(ov.y);
    float y2 = h2 * r * gg.z * sigmoidf_(ov.z);
    float y3 = h3 * r * gg.w * sigmoidf_(ov.w);
    *(uint2*)(YM + tok * DM + head * 64 + i16 * 4) = make_uint2(pack2(y0, y1), pack2(y2, y3));
  }
}

DI void phase_mixer(const Params& p, int lc, int kindmask, char* smem) {
  __shared__ int s_item;
  int* ctr = (int*)(pws(p, OFF_BAR)) + lc;
  const int l = lc & 1;
  bf16_t* YM = (bf16_t*)(pws(p, OFF_H));
  const bf16_t* QB = (const bf16_t*)(pws(p, OFF_QB));
  const bf16_t* QC = (const bf16_t*)(pws(p, OFF_QC));
  const bf16_t* KB = (const bf16_t*)(pws(p, OFF_KB));
  const bf16_t* VB = (const bf16_t*)(pws(p, OFF_VB));
  const bf16_t* KC = (const bf16_t*)(pws(p, OFF_KC));
  const bf16_t* VC = (const bf16_t*)(pws(p, OFF_VC));
  const int total = 32 + 128 + 256 + 128 + 128 + 128 + 128 + 1024 + 128;
  int* flags = (int*)(pws(p, OFF_BAR)) + FLAG_WORD0 + l * 80;
  while (true) {
    __syncthreads();
    if (otid() == 0) s_item = atomicAdd(ctr, 1);
    __syncthreads();
    int it = __builtin_amdgcn_readfirstlane(s_item);
    if (it >= total) break;
    int kind;
    bool lat = false, gl = false;
    int a0 = 0, a1 = 0, a2 = 0;
    if (it < 32) { kind = 0; lat = true; a0 = it >> 3; a1 = (it >> 1) & 3; a2 = it & 1; }
    else if ((it -= 32) < 128) { kind = 1; lat = true; gl = true; a0 = it >> 5; a1 = (it >> 3) & 3; a2 = it & 7; }
    else if ((it -= 128) < 256) { kind = 2; a0 = it >> 6; a1 = it & 63; }
    else if ((it -= 256) < 128) { kind = 1; lat = true; gl = false; a0 = it >> 5; a1 = (it >> 3) & 3; a2 = it & 7; }
    else if ((it -= 128) < 128) { kind = 0; lat = false; a0 = it >> 3; a1 = (it >> 1) & 3; a2 = it & 1; }
    else if ((it -= 128) < 128) { kind = 1; lat = false; gl = true; a0 = it >> 3; a1 = (it >> 1) & 3; a2 = it & 1; }
    else if ((it -= 128) < 128) { kind = 1; lat = false; gl = false; a0 = it >> 3; a1 = (it >> 1) & 3; a2 = it & 1; }
    else if ((it -= 128) < 1024) { kind = 3; a0 = it >> 6; a1 = it & 63; }
    else { it -= 1024; kind = 4; }
    if (kind == 4) {
      int tok0c, headc, fidx;
      if (it < 64) { const int sq = it >> 4; headc = (it >> 2) & 3; tok0c = NCTX + sq * 1024 + (it & 3) * 256; fidx = sq * 4 + headc; }
      else { const int sq = (it - 64) >> 2; headc = (it - 64) & 3; tok0c = sq * 256; fidx = 16 + sq * 4 + headc; }
      mlstm_combine_item(p, l, tok0c, headc, flags + fidx, YM);
      continue;
    }
    if (!((kindmask >> kind) & 1)) continue;
    if (kind == 0) {
#ifndef SKIP_MLSTM
      mlstm_dir_item(p, l, lat, a0, lat ? NCTX + a0 * 1024 : a0 * 256, lat ? 1024 : 256, a1, a2,
                     flags + (lat ? a0 * 4 + a1 : 16 + a0 * 4 + a1), smem);
#endif
    } else if (kind == 1) {
      const int head = a1, qb = a2;
      const int tok0 = lat ? NCTX + a0 * 1024 : a0 * 256;
      const size_t kr = (size_t)(lat ? NCTX + a0 * 1280 : tok0) * 128 + (head >> 1) * 64;
      int n1, start2 = 0, n2 = 0;
      if (lat && gl) n1 = 20;
      else if (lat) {
        const int lo = 2 * qb - 2 < 0 ? 0 : 2 * qb - 2, hi = 2 * qb + 3 > 15 ? 15 : 2 * qb + 3;
        n1 = 4; start2 = 4 + lo; n2 = hi - lo + 1;
      } else n1 = 4;
      const float sink = gl ? 0.f : pin(p, I_SINK)[l * 4 + head];
      attn_item((gl ? QB : QC) + (size_t)tok0 * 256 + head * 64, (gl ? KB : KC) + kr, (gl ? VB : VC) + kr, qb * 128, n1,
                start2, n2, lat && !gl, !gl, sink, YM + (size_t)tok0 * DM + (gl ? 256 : 512) + head * 64, smem);
    } else if (kind == 2) {
#ifndef SKIP_HYENA
      hyena_item<4>(p, l, NCTX + a0 * 1024, a1, YM, smem);
#endif
    } else {
#ifndef SKIP_HYENA
      hyena_item<1>(p, l, a0 * 256, a1, YM, smem);
#endif
    }
  }
}

__global__ void __launch_bounds__(256, 2) trunk_megakernel(Params p) {
  extern __shared__ __attribute__((aligned(16))) char smem[];
  cg::grid_group grid = cg::this_grid();
  __shared__ uint4 xb_words;
  if (threadIdx.x == 0) xb_words = make_uint4(0u, 0u, 0u, 0u);
  __syncthreads();
  if (p.out == nullptr) grid.sync();
  XcdBarrier xb = xcd_barrier_post((unsigned*)(pws(p, OFF_BAR)), (volatile LAS unsigned*)&xb_words);

#pragma unroll 1
  for (int ph = 0; ph < 24; ++ph) {
    const bf16_t* WT = (const bf16_t*)(pws(p, OFF_WT));
    const bf16_t* H = (const bf16_t*)(pws(p, OFF_H));
    float* X = (float*)(pws(p, OFF_X));
    float* U = (float*)(pws(p, OFF_U));
    bf16_t* ACT = (bf16_t*)(pws(p, OFF_U));
    const float* MOD = (const float*)(pws(p, OFF_MOD));
    if (ph == 0) {
#pragma unroll 1
      for (int rep = 0; rep < REP_PRO; ++rep) phase_prologue(p, smem);
    } else if (ph == 23) {
      phase_final_norm(p);
    } else {
      const int l = (ph - 1) / 11, s = (ph - 1) % 11;
      const float* modl = MOD + (size_t)l * 5 * NMOD;
      if (s == 0 || s == 3 || s == 8) {
        const float* g = (s == 0 ? pin(p, I_GFF1) : s == 3 ? pin(p, I_GMIX) : pin(p, I_GFF2)) + l * DM;
        const int ps = (s == 0) ? 0 : (s == 3) ? 3 : 6;
#pragma unroll 1
        for (int rep = 0; rep < REP_SMALL; ++rep)
          phase_norm(p, l, l == 0 && s == 0, g, ps, ps + 1);
        if (s == 0 && l == 1) {
#pragma unroll 1
          for (int rep = 0; rep < REP_PRO; ++rep) convert_layer(p, 1, smem);
        }
      } else if (s == 1 || s == 9) {
        EpiArgs ea{ACT, nullptr, nullptr, nullptr, 0.f};
#ifndef REP_GEMM
#define REP_GEMM 1
#endif
#pragma unroll 1
        for (int rep = 0; rep < REP_GEMM; ++rep)
        {
          gemm_k64<EPI_GU>(H, DM, WT + (s == 1 ? WT_GU1 : WT_GU2), DM, NTOK, NGU, DM, ea, smem);
        }
      } else if (s == 2 || s == 7 || s == 10) {
        const bool first = (l == 0 && s == 2);
        EpiArgs ea{X, first ? pin(p, I_XP) : X, first ? pin(p, I_XS) : X + (size_t)NCTX * DM,
                   modl + (s == 2 ? 2 : s == 7 ? 5 : 8) * 1024, s == 7 ? 1.0f : 0.5f};
        const bf16_t* A = (s == 7) ? H : ACT;
        const int K = (s == 7) ? DM : DFF;
        const bf16_t* B = WT + (s == 2 ? WT_D1 : s == 7 ? WT_OUT : WT_D2);
        gemm_k64<EPI_RES>(A, K, B, K, NTOK, DM, K, ea, smem);
#if REP_RES > 1
        {
          xcd_barrier(xb);
          EpiArgs eb{X, X, X + (size_t)NCTX * DM, ea.modp, 0.0f};
          gemm_k64<EPI_RES>(A, K, B, K, NTOK, DM, K, eb, smem);
        }
#endif
      } else if (s == 4) {
        EpiArgs ea{U, nullptr, nullptr, nullptr, 0.f};
#pragma unroll 1
        for (int rep = 0; rep < REP_GEMM; ++rep)
          gemm_k64<EPI_U>(H, DM, WT + WT_IN, DM, NTOK, NIN, DM, ea, smem);
      } else if (s == 5) {
#ifndef REP_SMALL
#define REP_SMALL 1
#endif
#pragma unroll 1
        for (int rep = 0; rep < REP_SMALL; ++rep)
          phase_prep(p, l);
      } else {
#ifndef REP_MIXER
#define REP_MIXER 1
#endif
#pragma unroll 1
        for (int rep = 0; rep < REP_MIXER; ++rep)
          phase_mixer(p, l + 2 * rep, rep == 0 ? 15 : REP_MASK, smem);
      }
    }
    if (ph < 23) {
      xcd_barrier(xb);
#if REP_BAR > 1
      xcd_barrier(xb);
#endif
    }
  }
}

extern "C" void kernel_launch(void* const* d_in, const int* in_sizes, int n_in, void* d_out, int out_size, void* d_ws,
                              size_t ws_size, hipStream_t stream) {
  static int grid_blocks = 0;
  if (!grid_blocks) {
    int dev = 0, cus = 0, per_cu = 0;
    hipGetDevice(&dev);
    hipDeviceGetAttribute(&cus, hipDeviceAttributeMultiprocessorCount, dev);
    hipFuncSetAttribute((const void*)trunk_megakernel, hipFuncAttributeMaxDynamicSharedMemorySize, LDS_BYTES);
    hipOccupancyMaxActiveBlocksPerMultiprocessor(&per_cu, trunk_megakernel, 256, LDS_BYTES);
    if (per_cu > 2) per_cu = 2;
    if (per_cu < 1) per_cu = 1;
    grid_blocks = cus * per_cu;
  }
  Params p{};
  for (int i = 0; i < 40; ++i) p.in[i] = (const float*)d_in[i];
  p.out = (float*)d_out;
  p.ws = (char*)d_ws;
  hipMemsetAsync((char*)d_ws + OFF_BAR, 0, 16384, stream);
  void* args[] = {&p};
  hipError_t e = hipLaunchCooperativeKernel((void*)trunk_megakernel, dim3(grid_blocks), dim3(256), args, LDS_BYTES, stream);
  if (e != hipSuccess) fprintf(stderr, "cooperative launch failed: %s (grid %d)\n", hipGetErrorString(e), grid_blocks);
}

#ifdef PROBE_PHASES
__global__ void __launch_bounds__(256, 2) k_mod(Params p) { extern __shared__ __attribute__((aligned(16))) char smem[]; mod_item(p, blockIdx.x, smem); }
__global__ void __launch_bounds__(256, 2) k_filt(Params p) { extern __shared__ __attribute__((aligned(16))) char smem[]; filt_item(p, blockIdx.x, smem); }
__global__ void __launch_bounds__(256, 2) k_conv(Params p) { extern __shared__ __attribute__((aligned(16))) char smem[]; convert_layer(p, 0, smem); }
__global__ void __launch_bounds__(256, 2) k_pro(Params p) { extern __shared__ __attribute__((aligned(16))) char smem[]; phase_prologue(p, smem); }
__global__ void __launch_bounds__(256, 2) k_norm(Params p) { phase_norm(p, 0, true, p.in[I_GFF1], 0, 1); }
__global__ void __launch_bounds__(256, 2) k_gemm_gu(Params p) { extern __shared__ __attribute__((aligned(16))) char smem[]; EpiArgs ea{p.ws, nullptr, nullptr, nullptr, 0.f}; gemm_phase<EPI_GU>((bf16_t*)p.ws, DM, (bf16_t*)p.ws, DM, NTOK, NGU, DM, ea, smem); }
__global__ void __launch_bounds__(256, 2) k_gemm_res(Params p) { extern __shared__ __attribute__((aligned(16))) char smem[]; EpiArgs ea{p.ws, p.in[0], p.in[1], p.in[2], 0.5f}; gemm_phase<EPI_RES>((bf16_t*)p.ws, DM, (bf16_t*)p.ws, DM, NTOK, DM, DM, ea, smem); }
__global__ void __launch_bounds__(256, 2) k_gemm_u(Params p) { extern __shared__ __attribute__((aligned(16))) char smem[]; EpiArgs ea{p.ws, nullptr, nullptr, nullptr, 0.f}; gemm_phase<EPI_U>((bf16_t*)p.ws, DM, (bf16_t*)p.ws, DM, NTOK, NIN, DM, ea, smem); }
__global__ void __launch_bounds__(256, 2) k_prep(Params p) { phase_prep(p, 0); }
__global__ void __launch_bounds__(256, 2) k_attn(Params p, int a, int b, int c, int d, bool w, bool hs, float sk) { extern __shared__ __attribute__((aligned(16))) char smem[]; attn_item((bf16_t*)p.ws, (bf16_t*)p.ws, (bf16_t*)p.ws, a, b, c, d, w, hs, sk, (bf16_t*)p.ws, smem); }
__global__ void __launch_bounds__(256, 2) k_hy4(Params p) { extern __shared__ __attribute__((aligned(16))) char smem[]; hyena_item<4>(p, 0, 0, blockIdx.x, (bf16_t*)p.ws, smem); }
__global__ void __launch_bounds__(256, 2) k_hy1(Params p) { extern __shared__ __attribute__((aligned(16))) char smem[]; hyena_item<1>(p, 0, 0, blockIdx.x, (bf16_t*)p.ws, smem); }
__global__ void __launch_bounds__(256, 2) k_mixer(Params p) { extern __shared__ __attribute__((aligned(16))) char smem[]; phase_mixer(p, 0, 15, smem); }
#endif
```
